# Optimizing an MI355X kernel written in HIP

```python
import math
import jax, jax.numpy as jnp
from jax import lax
import numpy as np

D_MODEL = 1024
BATCH = 2
SEQ = 8192
DEPTH = 4

GRID_W = 64
CTX_LEN = 256
N_MIXERS = 2
N_MLA_LAYERS = (DEPTH + N_MIXERS - 1) // N_MIXERS
N_POOL_LAYERS = DEPTH // N_MIXERS
MLA_HEADS = 8
QK_NOPE_DIM = 128
QK_ROPE_DIM = 64
V_HEAD_DIM = 128
Q_LORA_RANK = 384
KV_LORA_RANK = 256
MLA_IN_DIM = Q_LORA_RANK + KV_LORA_RANK + QK_ROPE_DIM
ROPE_THETA = 10000.0
Q_BLOCK = 128
POOL_WINDOWS = (2, 4, 8, 16)
N_POOL_GROUPS = 4
POOL_GROUP_DIM = D_MODEL // N_POOL_GROUPS
PEER_HEADS = 8
PEER_N_KEYS = 128
PEER_N_EXPERTS = PEER_N_KEYS * PEER_N_KEYS
PEER_QUERY_DIM = 256
PEER_HALF = PEER_QUERY_DIM // 2
PEER_TOPK = 16
PEER_BLOCK = 128
LN_EPS = 1e-5
RMS_EPS = 1e-6
DEEPNORM_ALPHA = (2.0 * DEPTH) ** 0.25
DEEPNORM_BETA = (8.0 * DEPTH) ** -0.25
N_MOD = 6

kernel_name = "hybrid_mla_pool_peer_prefix_dit"


def _layernorm(x, g, b):
    xf = x.astype(jnp.float32)
    mu = jnp.mean(xf, axis=-1, keepdims=True)
    var = jnp.mean(jnp.square(xf - mu), axis=-1, keepdims=True)
    return ((xf - mu) * lax.rsqrt(var + LN_EPS) * g + b).astype(x.dtype)


def _rmsnorm(x, g):
    xf = x.astype(jnp.float32)
    return (xf * lax.rsqrt(jnp.mean(jnp.square(xf), axis=-1, keepdims=True) + RMS_EPS) * g).astype(x.dtype)


def _axial_rope_tables(n_tokens):
    rows_n = n_tokens // GRID_W
    row = jnp.repeat(jnp.arange(rows_n), GRID_W).astype(jnp.float32)
    col = jnp.tile(jnp.arange(GRID_W), rows_n).astype(jnp.float32)
    n_freq = QK_ROPE_DIM // 4
    freqs = ROPE_THETA ** (-jnp.arange(n_freq, dtype=jnp.float32) / n_freq)
    ang = jnp.concatenate([row[:, None] * freqs, col[:, None] * freqs], axis=-1)
    return jnp.cos(ang), jnp.sin(ang)


def _apply_rope(x, cos, sin):
    half = x.shape[-1] // 2
    xf = x.astype(jnp.float32)
    x1, x2 = xf[..., :half], xf[..., half:]
    return jnp.concatenate([x1 * cos - x2 * sin, x1 * sin + x2 * cos], axis=-1).astype(x.dtype)


def _block_attention(q, k, v):
    b, s, h, dk = q.shape
    scale = dk ** -0.5
    qb = q.reshape(b, s // Q_BLOCK, Q_BLOCK, h, dk).transpose(1, 0, 2, 3, 4)

    def one(qblk):
        sc = jnp.einsum('bqhd,bkhd->bhqk', qblk, k, preferred_element_type=jnp.float32) * scale
        p = jax.nn.softmax(sc, axis=-1).astype(v.dtype)
        return jnp.einsum('bhqk,bkhd->bqhd', p, v)

    o = lax.map(one, qb)
    return o.transpose(1, 0, 2, 3, 4).reshape(b, s, h * v.shape[-1])


def _mla_qkv(h, rope, w_in, q_norm_g, kv_norm_g, w_uq, w_ukv, with_queries):
    b, l, _ = h.shape
    z = h @ w_in
    c_q = z[..., :Q_LORA_RANK]
    c_kv = z[..., Q_LORA_RANK:Q_LORA_RANK + KV_LORA_RANK]
    k_rope = z[..., Q_LORA_RANK + KV_LORA_RANK:]
    kv = (_rmsnorm(c_kv, kv_norm_g) @ w_ukv).reshape(b, l, MLA_HEADS, QK_NOPE_DIM + V_HEAD_DIM)
    k_nope, v = kv[..., :QK_NOPE_DIM], kv[..., QK_NOPE_DIM:]
    if rope is not None:
        cos, sin = rope
        k_rope = _apply_rope(k_rope, cos, sin)
    k = jnp.concatenate([k_nope, jnp.broadcast_to(k_rope[:, :, None, :], (b, l, MLA_HEADS, QK_ROPE_DIM))], axis=-1)
    if not with_queries:
        return None, k, v
    q = (_rmsnorm(c_q, q_norm_g) @ w_uq).reshape(b, l, MLA_HEADS, QK_NOPE_DIM + QK_ROPE_DIM)
    q_nope, q_rope = q[..., :QK_NOPE_DIM], q[..., QK_NOPE_DIM:]
    if rope is not None:
        q_rope = _apply_rope(q_rope, cos[:, None, :], sin[:, None, :])
    return jnp.concatenate([q_nope, q_rope], axis=-1), k, v


def _centred_mean_minus_self(x, window):
    b, l, ch = x.shape
    xf = x.astype(jnp.float32)
    cs = jnp.concatenate([jnp.zeros((b, 1, ch), jnp.float32), jnp.cumsum(xf, axis=1)], axis=1)
    t = jnp.arange(l)
    lo = jnp.clip(t - window // 2, 0, l)
    hi = jnp.clip(t + window // 2, 0, l)
    tot = jnp.take(cs, hi, axis=1) - jnp.take(cs, lo, axis=1)
    cnt = (hi - lo).astype(jnp.float32)[None, :, None]
    return (tot / cnt - xf).astype(x.dtype)


def _pool_mixer(h, w_in, w_grp, scale, w_out):
    b, l, _ = h.shape
    zg = (h @ w_in).reshape(b, l, N_POOL_GROUPS, POOL_GROUP_DIM)
    pooled = jnp.stack([_centred_mean_minus_self(zg[:, :, g], POOL_WINDOWS[g]) for g in range(N_POOL_GROUPS)], axis=2)
    y = jnp.einsum('blgc,gcd->blgd', pooled, w_grp).reshape(b, l, D_MODEL) * scale
    return y @ w_out


def _peer(h, w_q, k1, k2, u_tab, v_tab):
    b, l, d = h.shape
    q = (h @ w_q).reshape(b, l, PEER_HEADS, 2, PEER_HALF)
    s1 = jnp.einsum('blhc,hnc->blhn', q[..., 0, :], k1, preferred_element_type=jnp.float32)
    s2 = jnp.einsum('blhc,hnc->blhn', q[..., 1, :], k2, preferred_element_type=jnp.float32)
    v1, i1 = lax.top_k(s1, PEER_TOPK)
    v2, i2 = lax.top_k(s2, PEER_TOPK)
    cand_s = (v1[..., :, None] + v2[..., None, :]).reshape(b, l, PEER_HEADS, PEER_TOPK * PEER_TOPK)
    cand_i = (i1[..., :, None] * PEER_N_KEYS + i2[..., None, :]).reshape(b, l, PEER_HEADS, PEER_TOPK * PEER_TOPK)
    top_s, pos = lax.top_k(cand_s, PEER_TOPK)
    idx = jnp.take_along_axis(cand_i, pos, axis=-1)
    g = jax.nn.softmax(top_s, axis=-1).astype(h.dtype)
    n_blk = (b * l) // PEER_BLOCK
    n_sel = PEER_HEADS * PEER_TOPK
    hb = h.reshape(n_blk, PEER_BLOCK, d)
    ib = idx.reshape(n_blk, PEER_BLOCK, n_sel)
    gb = g.reshape(n_blk, PEER_BLOCK, n_sel)

    def one(args):
        hx, ix, gx = args
        u = jnp.take(u_tab, ix, axis=0)
        a = jax.nn.gelu(jnp.einsum('ted,td->te', u, hx), approximate=False)
        vv = jnp.take(v_tab, ix, axis=0)
        return jnp.einsum('te,ted->td', gx * a, vv)

    return lax.map(one, (hb, ib, gb)).reshape(b, l, d)


def _post_norm(x, y, gate, g, b):
    return _layernorm(DEEPNORM_ALPHA * x + gate * y, g, b)


def setup_inputs(seed: int = 0) -> dict:
    key = jax.random.key(seed)
    ks = jax.random.split(key, 24)
    nrm = lambda k, shp, s: jax.random.normal(k, shp, jnp.float32) * s
    D = D_MODEL
    return {
        "x": nrm(ks[0], (BATCH, SEQ, D), 1.0),
        "c": nrm(ks[1], (BATCH, D), 1.0),
        "ctx": nrm(ks[2], (BATCH, CTX_LEN, D), 1.0),
        "c_ctx": nrm(ks[3], (D,), 1.0),
        "w_mod": nrm(ks[4], (DEPTH, D, N_MOD * D), 0.5 * D ** -0.5),
        "b_mod": nrm(ks[5], (DEPTH, N_MOD * D), 0.02),
        "ln_g": 1.0 + nrm(ks[6], (DEPTH, 2, D), 0.05),
        "ln_b": nrm(ks[7], (DEPTH, 2, D), 0.02),
        "mla_w_in": nrm(ks[8], (N_MLA_LAYERS, D, MLA_IN_DIM), D ** -0.5),
        "mla_q_norm": 1.0 + nrm(ks[9], (N_MLA_LAYERS, Q_LORA_RANK), 0.05),
        "mla_kv_norm": 1.0 + nrm(ks[10], (N_MLA_LAYERS, KV_LORA_RANK), 0.05),
        "mla_w_uq": nrm(ks[11], (N_MLA_LAYERS, Q_LORA_RANK, MLA_HEADS * (QK_NOPE_DIM + QK_ROPE_DIM)), Q_LORA_RANK ** -0.5),
        "mla_w_ukv": nrm(ks[12], (N_MLA_LAYERS, KV_LORA_RANK, MLA_HEADS * (QK_NOPE_DIM + V_HEAD_DIM)), KV_LORA_RANK ** -0.5),
        "mla_w_o": nrm(ks[13], (N_MLA_LAYERS, MLA_HEADS * V_HEAD_DIM, D), DEEPNORM_BETA * (MLA_HEADS * V_HEAD_DIM) ** -0.5),
        "pool_w_in": nrm(ks[14], (N_POOL_LAYERS, D, D), D ** -0.5),
        "pool_w_grp": nrm(ks[15], (N_POOL_LAYERS, N_POOL_GROUPS, POOL_GROUP_DIM, POOL_GROUP_DIM), POOL_GROUP_DIM ** -0.5),
        "pool_scale": 1.0 + nrm(ks[16], (N_POOL_LAYERS, D), 0.1),
        "pool_w_out": nrm(ks[17], (N_POOL_LAYERS, D, D), DEEPNORM_BETA * D ** -0.5),
        "peer_w_q": nrm(ks[18], (DEPTH, D, PEER_HEADS * PEER_QUERY_DIM), D ** -0.5),
        "peer_k1": nrm(ks[19], (DEPTH, PEER_HEADS, PEER_N_KEYS, PEER_HALF), PEER_HALF ** -0.5),
        "peer_k2": nrm(ks[20], (DEPTH, PEER_HEADS, PEER_N_KEYS, PEER_HALF), PEER_HALF ** -0.5),
        "peer_u": nrm(ks[21], (DEPTH, PEER_N_EXPERTS, D), D ** -0.5),
        "peer_v": nrm(ks[22], (DEPTH, PEER_N_EXPERTS, D), DEEPNORM_BETA),
    }


def reference(x, c, ctx, c_ctx, w_mod, b_mod, ln_g, ln_b, mla_w_in, mla_q_norm, mla_kv_norm, mla_w_uq, mla_w_ukv, mla_w_o,
              pool_w_in, pool_w_grp, pool_scale, pool_w_out, peer_w_q, peer_k1, peer_k2, peer_u, peer_v):
    b, s, _ = x.shape
    rope = _axial_rope_tables(s)
    silu_c = jax.nn.silu(c)
    silu_ctx = jax.nn.silu(c_ctx)
    for i in range(DEPTH):
        mixer = i % N_MIXERS
        j = i // N_MIXERS
        ctx_needed = any(k % N_MIXERS == 0 for k in range(i + 1, DEPTH))
        ml = (silu_c @ w_mod[i] + b_mod[i])[:, None, :]
        mc = silu_ctx @ w_mod[i] + b_mod[i]
        sh1, sc1, g1, sh2, sc2, g2 = jnp.split(ml, N_MOD, axis=-1)
        csh1, csc1, cg1, csh2, csc2, cg2 = jnp.split(mc, N_MOD, axis=-1)
        hx = x * (1.0 + sc1) + sh1
        hc = ctx * (1.0 + csc1) + csh1
        if mixer == 0:
            w = (mla_w_in[j], mla_q_norm[j], mla_kv_norm[j], mla_w_uq[j], mla_w_ukv[j])
            q, k, v = _mla_qkv(hx, rope, *w, True)
            qc, kc, vc = _mla_qkv(hc, None, *w, ctx_needed)
            y = _block_attention(q, jnp.concatenate([k, kc], axis=1), jnp.concatenate([v, vc], axis=1)) @ mla_w_o[j]
            if ctx_needed:
                yc = _block_attention(qc, kc, vc) @ mla_w_o[j]
        else:
            w = (pool_w_in[j], pool_w_grp[j], pool_scale[j], pool_w_out[j])
            y = _pool_mixer(hx, *w)
            if ctx_needed:
                yc = _pool_mixer(hc, *w)
        pw = (peer_w_q[i], peer_k1[i], peer_k2[i], peer_u[i], peer_v[i])
        x = _post_norm(x, y, g1, ln_g[i, 0], ln_b[i, 0])
        x = _post_norm(x, _peer(x * (1.0 + sc2) + sh2, *pw), g2, ln_g[i, 1], ln_b[i, 1])
        if ctx_needed:
            ctx = _post_norm(ctx, yc, cg1, ln_g[i, 0], ln_b[i, 0])
            ctx = _post_norm(ctx, _peer(ctx * (1.0 + csc2) + csh2, *pw), cg2, ln_g[i, 1], ln_b[i, 1])
    return x
```

```cpp
#include <hip/hip_runtime.h>
#include <hip/hip_cooperative_groups.h>
#include <cstdio>
#include <cstdint>
#include <cstring>
namespace cg = cooperative_groups;

#ifndef MK_ONE_LAUNCH
#define MK_ONE_LAUNCH 1
#endif

#ifndef PROBE_PH
#define PROBE_PH -1
#endif
#ifndef PROBE_N
#define PROBE_N 0
#endif
#ifndef PROBE_MODE
#define PROBE_MODE 0
#endif
#define DEV __device__ __forceinline__
#define PHASE __device__ __forceinline__
typedef _Float16 hf;
typedef _Float16 h2v __attribute__((ext_vector_type(2)));
typedef _Float16 h4v __attribute__((ext_vector_type(4)));
typedef _Float16 h8v __attribute__((ext_vector_type(8)));
typedef short s4v __attribute__((ext_vector_type(4)));
typedef float f4v __attribute__((ext_vector_type(4)));
typedef float f16v __attribute__((ext_vector_type(16)));
typedef unsigned u4v __attribute__((ext_vector_type(4)));
typedef int i4v __attribute__((ext_vector_type(4)));
typedef float f2v __attribute__((ext_vector_type(2)));

constexpr int DM = 1024, NB = 2, SEQ = 8192, DEPTH = 4, CTXL = 256;
constexpr int NTOK = NB * SEQ;
constexpr int NCTX = NB * CTXL;
constexpr int MALL = NTOK + NCTX;
constexpr int TKV = SEQ + CTXL;
constexpr int NH = 8, DK = 192, DV = 128;
constexpr int NEXP = 16384;
constexpr float ALPHA = 1.681792830507429f;
constexpr float LN_EPS = 1e-5f, RMS_EPS = 1e-6f;
constexpr int NTHR = 512;

constexpr size_t al256(size_t x) { return (x + 255) & ~(size_t)255; }
constexpr size_t OFF_BAR = 0;
constexpr size_t OFF_MOD = 16384;
constexpr size_t OFF_ROPE = OFF_MOD + al256((size_t)4 * 3 * 6144 * 4);
constexpr size_t OFF_X = OFF_ROPE + (size_t)2 * 8192 * 32 * 4;
constexpr size_t SZ_A32 = (size_t)MALL * 1024 * 4, SZ_A16 = (size_t)MALL * 1024 * 2;
constexpr size_t OFF_H = OFF_X + SZ_A32;
constexpr size_t OFF_Z = OFF_H + SZ_A16;
constexpr size_t OFF_ATT = OFF_Z + SZ_A16;
constexpr size_t OFF_Y = OFF_ATT + SZ_A16;
constexpr size_t OFF_PQ = OFF_Y + SZ_A16;
constexpr size_t OFF_Q = OFF_PQ + 2 * SZ_A16;
constexpr size_t OFF_QC = OFF_Q + (size_t)NB * NH * SEQ * DK * 2;
constexpr size_t OFF_K = OFF_QC + (size_t)NB * NH * CTXL * DK * 2;
constexpr size_t OFF_KR = OFF_K + (size_t)NB * NH * TKV * 128 * 2;
constexpr size_t OFF_V = OFF_KR + (size_t)NB * TKV * 64 * 2;
constexpr size_t OFF_IDX = OFF_V + (size_t)NB * NH * TKV * DV * 2;
constexpr size_t OFF_G = OFF_IDX + (size_t)MALL * 128 * 4;
constexpr size_t OFF_WIN = OFF_G + (size_t)MALL * 128 * 4;
constexpr size_t OFF_WUQ = OFF_WIN + (size_t)2 * 768 * 1024 * 2;
constexpr size_t OFF_WUKV = OFF_WUQ + (size_t)2 * 1536 * 384 * 2;
constexpr size_t OFF_WO = OFF_WUKV + (size_t)2 * 2048 * 256 * 2;
constexpr size_t OFF_PWIN = OFF_WO + (size_t)2 * 1024 * 1024 * 2;
constexpr size_t OFF_PGRP = OFF_PWIN + (size_t)2 * 1024 * 1024 * 2;
constexpr size_t OFF_PWOUT = OFF_PGRP + (size_t)2 * 1024 * 256 * 2;
constexpr size_t OFF_PEERWQ = OFF_PWOUT + (size_t)2 * 1024 * 1024 * 2;
constexpr size_t OFF_K1 = OFF_PEERWQ + (size_t)4 * 2048 * 1024 * 2;
constexpr size_t OFF_K2 = OFF_K1 + (size_t)4 * 8 * 128 * 128 * 2;
constexpr size_t OFF_U8 = OFF_K2 + (size_t)4 * 8 * 128 * 128 * 2;
constexpr size_t OFF_V8 = OFF_U8 + (size_t)4 * NEXP * 1024;
constexpr size_t OFF_SU = OFF_V8 + (size_t)4 * NEXP * 1024;
constexpr size_t OFF_SV = OFF_SU + (size_t)4 * NEXP * 4;
constexpr size_t OFF_PD = OFF_SV + (size_t)4 * NEXP * 4;
constexpr size_t OFF_W = OFF_PD + (size_t)8 * MALL * 128 * 4;
constexpr size_t OFF_RSSP = OFF_W + (size_t)MALL * 128 * 4;
constexpr size_t WS_END = OFF_RSSP + (size_t)MALL * 8 * 4;

struct TJob { const float* src; hf* dst; const float* gs; int K, N, Npad, tile0; };
constexpr int NJOBS = 28;
struct Params {
  const float* in[23];
  float* out;
  char* ws;
  TJob jobs[NJOBS];
  int njobs, ntiles, pad0, pad1;
};
typedef const __attribute__((address_space(4))) Params* PP;
enum { I_X = 0, I_C, I_CTX, I_CCTX, I_WMOD, I_BMOD, I_LNG, I_LNB, I_MWIN, I_MQN, I_MKVN, I_MWUQ, I_MWUKV, I_MWO, I_PWIN, I_PGRP, I_PSCALE, I_PWOUT, I_EWQ, I_EK1, I_EK2, I_EU, I_EV };

DEV int get_tid() { int t = __builtin_amdgcn_workitem_id_x(); asm volatile("" : "+v"(t)); return t; }
DEV int crow(int r, int hi) { return (r & 3) + 8 * (r >> 2) + 4 * hi; }
DEV float wave_sum(float v) {
#pragma unroll
  for (int o = 32; o > 0; o >>= 1) v += __shfl_xor(v, o);
  return v;
}
DEV float dot8(h8v a, h8v b, float c) {
  const h2v* pa = (const h2v*)&a; const h2v* pb = (const h2v*)&b;
#pragma unroll
  for (int i = 0; i < 4; ++i) c = __builtin_amdgcn_fdot2(pa[i], pb[i], c, false);
  return c;
}
DEV float silu(float x) { return x / (1.f + __expf(-x)); }

constexpr int G_BM = 256, G_BN = 128, G_BK = 64;
constexpr int LDS_A_BYTES = G_BM * G_BK * 2, LDS_B_BYTES = G_BN * G_BK * 2;
constexpr int G_STAGES = 3;
constexpr int LDS_RS_OFF = G_STAGES * (LDS_A_BYTES + LDS_B_BYTES);
constexpr int NQL = 0;
constexpr int LDS_ATT = 3 * 16384 + 3 * 24576 + 2048 + 8 * NQL * 1024, LDS_GEMM = LDS_RS_OFF + 2048;
constexpr int LDS_TOTAL = LDS_ATT > LDS_GEMM ? LDS_ATT : LDS_GEMM;
DEV int swz(int row, int ch) { return row * 128 + ((ch ^ ((row >> 1) & 7)) << 4); }
DEV void glds16(const hf* src, char* lds_dst) { __builtin_amdgcn_global_load_lds((const unsigned*)src, (unsigned __attribute__((address_space(3)))*)lds_dst, 16, 0, 0); }


DEV h4v pack4(float a, float b, float c, float d) { h4v t; t[0] = (hf)a; t[1] = (hf)b; t[2] = (hf)c; t[3] = (hf)d; return t; }
DEV void stage_rows(char* stage, const float (&f)[2][16], int r32, int hi, hf* dst0, int stride) {
  const int lane = r32 + 32 * hi;
#pragma unroll
  for (int ni = 0; ni < 2; ++ni)
#pragma unroll
    for (int g = 0; g < 4; ++g) *(h4v*)(stage + r32 * 144 + (ni * 32 + g * 8 + 4 * hi) * 2) = pack4(f[ni][4 * g], f[ni][4 * g + 1], f[ni][4 * g + 2], f[ni][4 * g + 3]);
  asm volatile("s_waitcnt lgkmcnt(0)" ::: "memory");
  hf* dst = dst0 + (size_t)(lane >> 3) * stride + (lane & 7) * 8;
#pragma unroll
  for (int i = 0; i < 4; ++i) { const h8v v = *(const h8v*)(stage + (i * 8 + (lane >> 3)) * 144 + (lane & 7) * 16); *(h8v*)(dst + (size_t)(i * 8) * stride) = v; }
  asm volatile("s_waitcnt lgkmcnt(0)" ::: "memory");
}
struct EpiStore {
  static constexpr bool MINI_OK = true;
  hf* out; int ldo; const float* cscale;
  template <int MI> DEV void operator()(const f16v (&acc)[2][MI], int m0, int n0, int wr, int wc, int r32, int hi, float*, char* stage) const {
    const int cb = n0 + wc * 64 + 4 * hi;
    f4v cs[2][4];
#pragma unroll
    for (int ni = 0; ni < 2; ++ni)
#pragma unroll
      for (int g = 0; g < 4; ++g) { cs[ni][g] = (f4v){1.f, 1.f, 1.f, 1.f}; if (cscale) cs[ni][g] = *(const f4v*)(cscale + cb + ni * 32 + g * 8); }
#pragma unroll
    for (int mi = 0; mi < MI; ++mi) {
      float f[2][16];
#pragma unroll
      for (int ni = 0; ni < 2; ++ni)
#pragma unroll
        for (int r = 0; r < 16; ++r) f[ni][r] = acc[ni][mi][r] * cs[ni][r >> 2][r & 3];
      stage_rows(stage, f, r32, hi, out + (size_t)(m0 + wr * 64 + mi * 32) * ldo + n0 + wc * 64, ldo);
    }
  }
};
DEV bool tile_is_x(int m0) { return m0 < NTOK; }
DEV int tile_batch(int m0) { return m0 < NTOK ? (m0 >> 13) : ((m0 - NTOK) >> 8); }
DEV int tile_t0(int m0) { return m0 < NTOK ? (m0 & 8191) : SEQ + ((m0 - NTOK) & 255); }
struct EpiZ {
  static constexpr bool MINI_OK = false;
  hf* Z; hf* KR; const float* cosT; const float* sinT; float* RSSP;
  template <int MI> DEV void operator()(const f16v (&acc)[2][MI], int m0, int n0, int wr, int wc, int r32, int hi, float* rsl, char* stage) const {
    static_assert(MI == 2, "EpiZ reduces its row statistics across the workgroup: full tiles only");
#pragma unroll
    for (int mi = 0; mi < 2; ++mi) { float q = 0.f;
#pragma unroll
      for (int ni = 0; ni < 2; ++ni)
#pragma unroll
        for (int r = 0; r < 16; ++r) q = fmaf(acc[ni][mi][r], acc[ni][mi][r], q);
      { auto rr = __builtin_amdgcn_permlane32_swap(__float_as_uint(q), __float_as_uint(q), false, false); q = __uint_as_float(rr[0]) + __uint_as_float(rr[1]); }
      if (hi == 0) rsl[wc * 256 + wr * 64 + mi * 32 + r32] = q; }
    __syncthreads();
    { const int t = get_tid(); if (t < 256) RSSP[(size_t)(m0 + t) * 8 + (n0 >> 7)] = rsl[t] + rsl[256 + t]; }
    const bool isx = tile_is_x(m0);
#pragma unroll
    for (int mi = 0; mi < 2; ++mi) {
      const int lr = wr * 64 + mi * 32;
      float f[2][16];
#pragma unroll
      for (int ni = 0; ni < 2; ++ni)
#pragma unroll
        for (int r = 0; r < 16; ++r) f[ni][r] = acc[ni][mi][r];
      stage_rows(stage, f, r32, hi, Z + (size_t)(m0 + lr) * 768 + n0 + wc * 64, 768);
      if (n0 + wc * 64 == 640) {
        if (isx) { const int s = (m0 + lr + r32) & 8191;
#pragma unroll
          for (int g = 0; g < 4; ++g) { const f4v c = *(const f4v*)(cosT + s * 32 + g * 8 + 4 * hi), sn = *(const f4v*)(sinT + s * 32 + g * 8 + 4 * hi);
#pragma unroll
            for (int i = 0; i < 4; ++i) { const float x1 = acc[0][mi][4 * g + i], x2 = acc[1][mi][4 * g + i]; f[0][4 * g + i] = x1 * c[i] - x2 * sn[i]; f[1][4 * g + i] = x1 * sn[i] + x2 * c[i]; } } }
        stage_rows(stage, f, r32, hi, KR + ((size_t)tile_batch(m0) * TKV + tile_t0(m0) + lr) * 64, 64);
      }
    }
  }
};
struct EpiQ {
  static constexpr bool MINI_OK = true;
  hf* Q; hf* Qc; const float* cosT; const float* sinT; const float* RSSP;
  template <int MI> DEV void operator()(const f16v (&acc)[2][MI], int m0, int n0, int wr, int wc, int r32, int hi, float*, char* stage) const {
    const int cc = (n0 + wc * 64) >> 6, head = cc / 3, part = cc - head * 3;
    const bool isx = tile_is_x(m0); const int b = tile_batch(m0);
    hf* base = isx ? Q + ((size_t)(b * NH + head) * SEQ + (m0 & 8191)) * DK : Qc + ((size_t)(b * NH + head) * CTXL + ((m0 - NTOK) & 255)) * DK;
#pragma unroll
    for (int mi = 0; mi < MI; ++mi) {
      const int lr = wr * 64 + mi * 32, row = m0 + lr + r32; const float* pp = RSSP + (size_t)row * 8; const float sc = rsqrtf((pp[0] + pp[1] + pp[2]) * (1.f / 384.f) + RMS_EPS);
      float f[2][16];
      if (part == 2 && isx) { const int s = row & 8191;
#pragma unroll
        for (int g = 0; g < 4; ++g) { const f4v c = *(const f4v*)(cosT + s * 32 + g * 8 + 4 * hi), sn = *(const f4v*)(sinT + s * 32 + g * 8 + 4 * hi);
#pragma unroll
          for (int i = 0; i < 4; ++i) { const float x1 = acc[0][mi][4 * g + i] * sc, x2 = acc[1][mi][4 * g + i] * sc; f[0][4 * g + i] = x1 * c[i] - x2 * sn[i]; f[1][4 * g + i] = x1 * sn[i] + x2 * c[i]; } }
      } else {
#pragma unroll
        for (int ni = 0; ni < 2; ++ni)
#pragma unroll
          for (int r = 0; r < 16; ++r) f[ni][r] = acc[ni][mi][r] * sc;
      }
      stage_rows(stage, f, r32, hi, base + (size_t)lr * DK + part * 64, DK);
    }
  }
};
struct EpiKV {
  static constexpr bool MINI_OK = true;
  hf* Kb; long voff; const float* RSSP;
  template <int MI> DEV void operator()(const f16v (&acc)[2][MI], int m0, int n0, int wr, int wc, int r32, int hi, float*, char* stage) const {
    const int cc = (n0 + wc * 64) >> 6, head = cc >> 2, part = cc & 3;
    hf* base = Kb + (part >= 2 ? voff : 0l) + ((size_t)(tile_batch(m0) * NH + head) * TKV + tile_t0(m0)) * 128 + (part & 1) * 64;
#pragma unroll
    for (int mi = 0; mi < MI; ++mi) {
      const int lr = wr * 64 + mi * 32, row = m0 + lr + r32; const float* pp = RSSP + (size_t)row * 8; const float sc = rsqrtf((pp[3] + pp[4]) * (1.f / 256.f) + RMS_EPS);
      float f[2][16];
#pragma unroll
      for (int ni = 0; ni < 2; ++ni)
#pragma unroll
        for (int r = 0; r < 16; ++r) f[ni][r] = acc[ni][mi][r] * sc;
      stage_rows(stage, f, r32, hi, base + (size_t)lr * 128, 128);
    }
  }
};

template <class Epi>
DEV void gemm_mini(const hf* A, int lda, const hf* Bt, int ldb, int N, int K, int group_k, const Epi& epi, char* lds, int bid, int nblk, int mini0, int mini1) {
  if constexpr (Epi::MINI_OK) {
  if (mini1 <= mini0) return;
  const int tid = get_tid(), wid = tid >> 6, lane = tid & 63, r32 = lane & 31, hi = lane >> 5;
  char* stage = lds + 2 * LDS_A_BYTES + 8192;
  float* part = (float*)lds;
  const int ncb = N >> 6, items = ((mini1 - mini0) >> 5) * ncb, kw = K >> 3;
  for (int it = bid; it < items; it += nblk) {
    const int rb = it / ncb, cbk = it - rb * ncb, r0 = mini0 + rb * 32, c0 = cbk * 64;
    const hf* Ap = A + (group_k ? (c0 / group_k) * group_k : 0) + (size_t)(r0 + r32) * lda + hi * 8 + wid * kw;
    const hf* B0 = Bt + (size_t)(c0 + r32) * ldb + hi * 8 + wid * kw; const hf* B1 = B0 + (size_t)32 * ldb;
    f16v acc[2][1];
#pragma unroll
    for (int r = 0; r < 16; ++r) { acc[0][0][r] = 0.f; acc[1][0][r] = 0.f; }
#define MINI_K(NS) do { h8v a_[NS], b0_[NS], b1_[NS];                                                                                             \
      _Pragma("unroll") for (int ks = 0; ks < NS; ++ks) { a_[ks] = *(const h8v*)(Ap + ks * 16); b0_[ks] = *(const h8v*)(B0 + ks * 16); b1_[ks] = *(const h8v*)(B1 + ks * 16); } \
      _Pragma("unroll") for (int ks = 0; ks < NS; ++ks) { acc[0][0] = __builtin_amdgcn_mfma_f32_32x32x16_f16(b0_[ks], a_[ks], acc[0][0], 0, 0, 0);                           \
                                                          acc[1][0] = __builtin_amdgcn_mfma_f32_32x32x16_f16(b1_[ks], a_[ks], acc[1][0], 0, 0, 0); } } while (0)
    if (kw == 128) MINI_K(8); else if (kw == 48) MINI_K(3); else MINI_K(2);
#undef MINI_K
#pragma unroll
    for (int ni = 0; ni < 2; ++ni)
#pragma unroll
      for (int r = 0; r < 16; ++r) part[(wid * 32 + ni * 16 + r) * 64 + lane] = acc[ni][0][r];
    __syncthreads();
    { float* red = part + 8 * 32 * 64;
#pragma unroll
      for (int v = 0; v < 4; ++v) { const int idx = wid * 4 + v; float sacc = 0.f;
#pragma unroll
        for (int w = 0; w < 8; ++w) sacc += part[(w * 32 + idx) * 64 + lane];
        red[idx * 64 + lane] = sacc; }
      __syncthreads();
      if (wid == 0) {
#pragma unroll
        for (int ni = 0; ni < 2; ++ni)
#pragma unroll
          for (int r = 0; r < 16; ++r) acc[ni][0][r] = red[(ni * 16 + r) * 64 + lane];
        epi.template operator()<1>(acc, r0, c0, 0, 0, r32, hi, (float*)(lds + LDS_RS_OFF), stage);
      }
    }
    __syncthreads();
  }
  }
}
template <class Epi>
PHASE void gemm_phase(const hf* A, int lda, const hf* Bt, int ldb, int M, int N, int K, int group_k, const Epi& epi, char* lds, int bid, int nblk, bool dry, int mini0 = 0, int mini1 = 0) {
  const int ntn = N / G_BN, ntm = M / G_BM, x = bid & 7, nx8 = nblk >> 3;
  const int myM = (ntm - x + 7) >> 3, nitems = myM * ntn;
  const int tid = get_tid(), wid = tid >> 6, lane = tid & 63, r32 = lane & 31, hi = lane >> 5;
  const int wr = wid >> 1, wc = wid & 1;
  char* As = lds; char* Bs = lds + G_STAGES * LDS_A_BYTES;
  char* adst = As + (wid * 32) * 128; char* bdst = Bs + (wid * 16) * 128;
  char* stage = wid < 7 ? As + 2 * LDS_A_BYTES + wid * 4608 : Bs + 2 * LDS_B_BYTES;
  const int nk = K / G_BK;
  const hf* ag[4]; const hf* bg[2];
#define G_PTRS(m0_, n0_) do { const hf* Ap_ = A + (group_k ? ((n0_) / group_k) * group_k : 0);                                                             \
    _Pragma("unroll") for (int j = 0; j < 4; ++j) { const int r = wid * 32 + j * 8 + (lane >> 3), c = (lane & 7) ^ ((r >> 1) & 7); ag[j] = Ap_ + (size_t)((m0_) + r) * lda + c * 8; } \
    _Pragma("unroll") for (int j = 0; j < 2; ++j) { const int r = wid * 16 + j * 8 + (lane >> 3), c = (lane & 7) ^ ((r >> 1) & 7); bg[j] = Bt + (size_t)((n0_) + r) * ldb + c * 8; } } while (0)
#define G_ISSUE(buf, ko) do { if (dry && PROBE_MODE == 2) break; _Pragma("unroll") for (int j = 0; j < 4; ++j) glds16(ag[j] + (ko), adst + (buf) * LDS_A_BYTES + j * 1024); \
    _Pragma("unroll") for (int j = 0; j < 2; ++j) glds16(bg[j] + (ko), bdst + (buf) * LDS_B_BYTES + j * 1024); } while (0)
  int li = bid >> 3;
  if (bid >= nx8 * 8 || li >= nitems) { gemm_mini<Epi>(A, lda, Bt, ldb, N, K, group_k, epi, lds, bid, nblk, mini0, mini1); return; }
  int m0, n0;
  { const int q = li / ntn, nt = li - q * ntn; m0 = (x + 8 * q) * G_BM; n0 = nt * G_BN; }
  G_PTRS(m0, n0); G_ISSUE(0, 0); if (nk > 1) G_ISSUE(1, G_BK);
  for (;;) {
    f16v acc[2][2];
#pragma unroll
    for (int i = 0; i < 2; ++i)
#pragma unroll
      for (int j = 0; j < 2; ++j)
#pragma unroll
        for (int r = 0; r < 16; ++r) acc[i][j][r] = 0.f;
    int cur = 0;
    for (int kt = 0; kt < nk; ++kt) {
      if (kt + 1 < nk) asm volatile("s_waitcnt vmcnt(6) lgkmcnt(0)" ::: "memory"); else asm volatile("s_waitcnt vmcnt(0) lgkmcnt(0)" ::: "memory");
      __builtin_amdgcn_s_barrier();
      asm volatile("" ::: "memory");
      const bool pf = (kt + 2 < nk) && !(dry && PROBE_MODE == 2); const int nb = cur == 0 ? 2 : cur - 1; const int pko = (kt + 2) * G_BK;
      const char* Ab = As + cur * LDS_A_BYTES; const char* Bb = Bs + cur * LDS_B_BYTES;
      if (!(dry && PROBE_MODE == 3)) {
        h8v fa[2][2], fb[2][2];
#define G_FRAG(S, ks_) do { const int ch_ = (ks_) * 2 + hi; fa[S][0] = *(const h8v*)(Ab + swz(wr * 64 + r32, ch_)); fa[S][1] = *(const h8v*)(Ab + swz(wr * 64 + 32 + r32, ch_)); \
          fb[S][0] = *(const h8v*)(Bb + swz(wc * 64 + r32, ch_)); fb[S][1] = *(const h8v*)(Bb + swz(wc * 64 + 32 + r32, ch_)); } while (0)
        G_FRAG(0, 0);
#pragma unroll
        for (int ks = 0; ks < 4; ++ks) {
          const int S = ks & 1;
          if (ks < 3) G_FRAG(S ^ 1, ks + 1);
          if (pf && ks < 3) {
            if (ks < 2) { glds16(ag[2 * ks] + pko, adst + nb * LDS_A_BYTES + (2 * ks) * 1024); glds16(ag[2 * ks + 1] + pko, adst + nb * LDS_A_BYTES + (2 * ks + 1) * 1024); }
            else { glds16(bg[0] + pko, bdst + nb * LDS_B_BYTES); glds16(bg[1] + pko, bdst + nb * LDS_B_BYTES + 1024); }
          }
          acc[0][0] = __builtin_amdgcn_mfma_f32_32x32x16_f16(fb[S][0], fa[S][0], acc[0][0], 0, 0, 0);
          acc[0][1] = __builtin_amdgcn_mfma_f32_32x32x16_f16(fb[S][0], fa[S][1], acc[0][1], 0, 0, 0);
          acc[1][0] = __builtin_amdgcn_mfma_f32_32x32x16_f16(fb[S][1], fa[S][0], acc[1][0], 0, 0, 0);
          acc[1][1] = __builtin_amdgcn_mfma_f32_32x32x16_f16(fb[S][1], fa[S][1], acc[1][1], 0, 0, 0);
          __builtin_amdgcn_sched_barrier(0);
        }
#undef G_FRAG
      }
      cur = cur == 2 ? 0 : cur + 1;
    }
    asm volatile("s_waitcnt lgkmcnt(0)" ::: "memory");
    __syncthreads();
    const int cm0 = m0, cn0 = n0;
    li += nx8;
    const bool more = li < nitems;
    if (more) { const int q = li / ntn, nt = li - q * ntn; m0 = (x + 8 * q) * G_BM; n0 = nt * G_BN; G_PTRS(m0, n0); G_ISSUE(0, 0); if (nk > 1) G_ISSUE(1, G_BK); }
    if (dry && PROBE_MODE == 1) { float sink = 0.f;
#pragma unroll
      for (int i = 0; i < 2; ++i)
#pragma unroll
        for (int j = 0; j < 2; ++j)
#pragma unroll
          for (int r = 0; r < 16; ++r) sink += acc[i][j][r];
      if (sink == 1.2345e-30f) *(float*)(lds + LDS_RS_OFF) = sink; }
    else epi(acc, cm0, cn0, wr, wc, r32, hi, (float*)(lds + LDS_RS_OFF), stage);
    if (!more) break;
  }
#undef G_PTRS
#undef G_ISSUE
  __syncthreads();
  gemm_mini<Epi>(A, lda, Bt, ldb, N, K, group_k, epi, lds, bid, nblk, mini0, mini1);
}

constexpr int SHM_V = 64 * DV * 2, SHM_K = 64 * DK * 2;
#define KSWZ(row, colB) ((row) * 384 + ((colB) ^ ((((row) >> 1) & 7) << 4)))
#define SBAR() __builtin_amdgcn_sched_barrier(0)
constexpr float ATT_SCALE = 0.07216878364870322f;
constexpr float ATT_THR = 8.f;

DEV unsigned cvtpk(float lo, float hi) { h2v t; t.x = (hf)lo; t.y = (hf)hi; return *(unsigned*)&t; }

DEV void partialSM(f16v& p0, f16v& p1, float& m_reg, float& mn, float& alpha, bool dry = false) {
  if (dry && PROBE_MODE == 5) { mn = m_reg; alpha = 1.f; return; }
  constexpr float C = ATT_SCALE * 1.4426950408889634f;
  float pmax = p0[0];
#pragma unroll
  for (int r = 1; r < 16; ++r) pmax = fmaxf(pmax, p0[r]);
#pragma unroll
  for (int r = 0; r < 16; ++r) pmax = fmaxf(pmax, p1[r]);
  { auto rr = __builtin_amdgcn_permlane32_swap(__float_as_uint(pmax), __float_as_uint(pmax), false, false);
    pmax = fmaxf(__uint_as_float(rr[0]), __uint_as_float(rr[1])); }
  if (__builtin_expect(__all(pmax - m_reg <= ATT_THR / ATT_SCALE), 1)) { mn = m_reg; alpha = 1.f; }
  else { mn = fmaxf(m_reg, pmax); alpha = __builtin_amdgcn_exp2f((m_reg - mn) * C); m_reg = mn; }
  const float mnC = -mn * C;
#pragma unroll
  for (int r = 0; r < 16; ++r) p0[r] = fmaf(p0[r], C, mnC);
#pragma unroll
  for (int r = 0; r < 16; ++r) p1[r] = fmaf(p1[r], C, mnC);
#pragma unroll
  for (int r = 0; r < 16; ++r) p0[r] = __builtin_amdgcn_exp2f(p0[r]);
}
DEV void finishSM(f16v& p0, f16v& p1, float alpha, float& l_reg, h8v& pa0, h8v& pa1, h8v& pa2, h8v& pa3, bool dry = false) {
  if (dry && PROBE_MODE == 5) { l_reg += p0[0] + p1[0];
#pragma unroll
    for (int i = 0; i < 8; ++i) { pa0[i] = (hf)p0[i]; pa1[i] = (hf)p0[8 + i]; pa2[i] = (hf)p1[i]; pa3[i] = (hf)p1[8 + i]; } return; }
#pragma unroll
  for (int r = 0; r < 16; ++r) p1[r] = __builtin_amdgcn_exp2f(p1[r]);
  float ps = 0.f;
#pragma unroll
  for (int r = 0; r < 16; ++r) ps += p0[r];
#pragma unroll
  for (int r = 0; r < 16; ++r) ps += p1[r];
  { auto rr = __builtin_amdgcn_permlane32_swap(__float_as_uint(ps), __float_as_uint(ps), false, false);
    ps = __uint_as_float(rr[0]) + __uint_as_float(rr[1]); }
  l_reg = l_reg * alpha + ps;
#define PK4(P, BASE, OUT) do { unsigned a0 = cvtpk(P[BASE + 0], P[BASE + 1]), a1 = cvtpk(P[BASE + 2], P[BASE + 3]);   \
    unsigned b0 = cvtpk(P[BASE + 4], P[BASE + 5]), b1 = cvtpk(P[BASE + 6], P[BASE + 7]);                              \
    auto r0 = __builtin_amdgcn_permlane32_swap(a0, b0, false, false); auto r1 = __builtin_amdgcn_permlane32_swap(a1, b1, false, false); \
    u4v w = {r0[0], r1[0], r0[1], r1[1]}; OUT = *reinterpret_cast<h8v*>(&w); } while (0)
  PK4(p0, 0, pa0); PK4(p0, 8, pa1); PK4(p1, 0, pa2); PK4(p1, 8, pa3);
#undef PK4
}
DEV void qkt(f16v& p0, f16v& p1, const char* Ks, const h8v* qr, const char* qrl, int r32, int hi) {
#pragma unroll
  for (int r = 0; r < 16; ++r) { p0[r] = 0.f; p1[r] = 0.f; }
#pragma unroll
  for (int d0 = 0; d0 < 12; ++d0) {
    const int cb = (d0 * 16 + hi * 8) * 2;
    const h8v b0 = *reinterpret_cast<const h8v*>(Ks + KSWZ(r32, cb));
    const h8v b1 = *reinterpret_cast<const h8v*>(Ks + KSWZ(32 + r32, cb));
    const h8v q = d0 < 12 - NQL ? qr[d0 < 12 - NQL ? d0 : 0] : *reinterpret_cast<const h8v*>(qrl + (d0 - (12 - NQL)) * 1024);
    p0 = __builtin_amdgcn_mfma_f32_32x32x16_f16(b0, q, p0, 0, 0, 0);
    p1 = __builtin_amdgcn_mfma_f32_32x32x16_f16(b1, q, p1, 0, 0, 0);
  }
}
DEV int v_st(int k, int c) { const int kk = (k & ~0xC) | ((k & 4) << 1) | ((k & 8) >> 1); return ((kk >> 3) * 4 + (c >> 5)) * 512 + ((kk & 7) * 32 + (c & 31)) * 2; }
DEV int v_rd_base(int lane) { return ((lane & 3) << 3) | (((lane >> 2) & 3) << 6) | (((lane >> 4) & 1) << 5) | (((lane >> 5) & 1) << 8); }
constexpr int v_rd_off(int d0, int ks, int half) { return d0 * 512 + ks * 4096 + half * 2048; }
template <int OFF> DEV s4v tr_read(int vb) {
  s4v r; asm volatile("ds_read_b64_tr_b16 %0, %1 offset:%2" : "=&v"(r) : "v"(vb), "i"(OFF) : "memory"); return r;
}
template <int D0> DEV void pv_one(f16v& od, int vb, h8v pa0, h8v pa1, h8v pa2, h8v pa3) {
  const s4v l0 = tr_read<v_rd_off(D0, 0, 0)>(vb), h0 = tr_read<v_rd_off(D0, 0, 1)>(vb), l1 = tr_read<v_rd_off(D0, 1, 0)>(vb), h1 = tr_read<v_rd_off(D0, 1, 1)>(vb);
  const s4v l2 = tr_read<v_rd_off(D0, 2, 0)>(vb), h2 = tr_read<v_rd_off(D0, 2, 1)>(vb), l3 = tr_read<v_rd_off(D0, 3, 0)>(vb), h3 = tr_read<v_rd_off(D0, 3, 1)>(vb);
  asm volatile("s_waitcnt lgkmcnt(0)" ::: "memory"); SBAR();
#define PKV(L, H) ({ s4v l_ = (L), h_ = (H); short __attribute__((ext_vector_type(8))) t_ = {l_[0], l_[1], l_[2], l_[3], h_[0], h_[1], h_[2], h_[3]}; *reinterpret_cast<h8v*>(&t_); })
  od = __builtin_amdgcn_mfma_f32_32x32x16_f16(pa0, PKV(l0, h0), od, 0, 0, 0);
  od = __builtin_amdgcn_mfma_f32_32x32x16_f16(pa1, PKV(l1, h1), od, 0, 0, 0);
  od = __builtin_amdgcn_mfma_f32_32x32x16_f16(pa2, PKV(l2, h2), od, 0, 0, 0);
  od = __builtin_amdgcn_mfma_f32_32x32x16_f16(pa3, PKV(l3, h3), od, 0, 0, 0);
#undef PKV
}
DEV void pv_d0(f16v* o, int vb, h8v pa0, h8v pa1, h8v pa2, h8v pa3) {
  pv_one<0>(o[0], vb, pa0, pa1, pa2, pa3); pv_one<1>(o[1], vb, pa0, pa1, pa2, pa3); pv_one<2>(o[2], vb, pa0, pa1, pa2, pa3); pv_one<3>(o[3], vb, pa0, pa1, pa2, pa3);
}

DEV void attn_body(const hf* __restrict__ Qb, const hf* __restrict__ Kh, const hf* __restrict__ Rh, const hf* __restrict__ Vh, hf* __restrict__ Ob, int seq, char* lds, bool dry) {
  const int tid = get_tid(), wid = tid >> 6, lane = tid & 63, r32 = lane & 31, hi = lane >> 5;
  char* V_lds = lds; char* K_lds = lds + 2 * SHM_V;
  float* wsm = (float*)(lds + 2 * SHM_V + 2 * SHM_K) + wid * 64; float* li_l = wsm; float* al_l = wsm + 32;
  float m_reg = -1e30f, l_reg = 0.f; f16v o[4]; h8v qr[12 - NQL];
  char* qrl = lds + 2 * SHM_V + 2 * SHM_K + 2048 + wid * (NQL * 1024) + lane * 16;
#pragma unroll
  for (int d = 0; d < 4; ++d)
#pragma unroll
    for (int r = 0; r < 16; ++r) o[d][r] = 0.f;
  const hf* Qw = Qb + (size_t)(wid * 32 + r32) * DK + hi * 8;
#pragma unroll
  for (int d0 = 0; d0 < 12 - NQL; ++d0) qr[d0] = *(const h8v*)(Qw + d0 * 16);
#pragma unroll
  for (int d0 = 12 - NQL; d0 < 12; ++d0) *(h8v*)(qrl + (d0 - (12 - NQL)) * 1024) = *(const h8v*)(Qw + d0 * 16);
  const int sr = tid >> 4, sc = (tid & 15) * 8, vst0 = v_st(sr, sc), vst1 = v_st(32 + sr, sc);
  const int krow = tid >> 3, kch = tid & 7, kst = KSWZ(krow, kch * 16);
  const int vb0 = (int)(uintptr_t)V_lds + v_rd_base(lane);
  const hf* Vg = Vh + (size_t)sr * DV + sc; const hf* Kg = Kh + (size_t)krow * 128 + kch * 8; const hf* Rg = Rh + (size_t)krow * 64 + kch * 8;
  h8v vs0 = {}, vs1 = {}, ks0 = {}, ks1 = {}, ks2 = {};
#define SLOAD(k0) do { if (dry && PROBE_MODE == 6) break; vs0 = *(const h8v*)(Vg + (size_t)(k0) * DV); vs1 = *(const h8v*)(Vg + (size_t)((k0) + 32) * DV); \
    ks0 = *(const h8v*)(Kg + (size_t)(k0) * 128); ks1 = *(const h8v*)(Kg + (size_t)(k0) * 128 + 64); ks2 = *(const h8v*)(Rg + (size_t)(k0) * 64); } while (0)
#define SWRITE(b) do { if (dry && PROBE_MODE == 6) break; *(h8v*)(V_lds + (b) * SHM_V + vst0) = vs0; *(h8v*)(V_lds + (b) * SHM_V + vst1) = vs1;          \
    *(h8v*)(K_lds + (b) * SHM_K + kst) = ks0; *(h8v*)(K_lds + (b) * SHM_K + kst + 128) = ks1; *(h8v*)(K_lds + (b) * SHM_K + kst + 256) = ks2; } while (0)
#define RESC(a) do { if (__any((a) < 1.f)) { if (hi == 0) al_l[r32] = (a); asm volatile("s_waitcnt lgkmcnt(0)" ::: "memory"); \
    _Pragma("unroll") for (int d = 0; d < 4; ++d) _Pragma("unroll") for (int r = 0; r < 16; ++r) o[d][r] *= al_l[crow(r, hi)]; } } while (0)
  f16v pA0, pA1, pB0, pB1; float mnA, mnB, alA, alB; h8v pa0, pa1, pa2, pa3; const int NT = seq / 64;
  SLOAD(0); SWRITE(0); __syncthreads();
  qkt(pA0, pA1, K_lds, qr, qrl, r32, hi); partialSM(pA0, pA1, m_reg, mnA, alA, dry);
  SLOAD(64);
  SWRITE(1); __syncthreads();
  for (int j = 1; j + 1 < NT; j += 2) {
    SBAR(); qkt(pB0, pB1, K_lds + SHM_K, qr, qrl, r32, hi);
    finishSM(pA0, pA1, alA, l_reg, pa0, pa1, pa2, pa3, dry); SBAR();
    SLOAD((j + 1) * 64); SBAR();
    if (!(dry && PROBE_MODE == 4)) pv_d0(o, vb0, pa0, pa1, pa2, pa3); partialSM(pB0, pB1, m_reg, mnB, alB, dry);
    __syncthreads(); SWRITE(0);
    RESC(alB); __syncthreads();
    SBAR(); qkt(pA0, pA1, K_lds, qr, qrl, r32, hi);
    finishSM(pB0, pB1, alB, l_reg, pa0, pa1, pa2, pa3, dry); SBAR();
    SLOAD((j + 2) * 64); SBAR();
    if (!(dry && PROBE_MODE == 4)) pv_d0(o, vb0 + SHM_V, pa0, pa1, pa2, pa3); partialSM(pA0, pA1, m_reg, mnA, alA, dry);
    __syncthreads(); SWRITE(1);
    RESC(alA); __syncthreads();
  }
  SBAR(); qkt(pB0, pB1, K_lds + SHM_K, qr, qrl, r32, hi);
  finishSM(pA0, pA1, alA, l_reg, pa0, pa1, pa2, pa3, dry); SBAR();
  if (!(dry && PROBE_MODE == 4)) pv_d0(o, vb0, pa0, pa1, pa2, pa3); partialSM(pB0, pB1, m_reg, mnB, alB, dry);
  __syncthreads(); RESC(alB);
  finishSM(pB0, pB1, alB, l_reg, pa0, pa1, pa2, pa3, dry); SBAR();
  if (!(dry && PROBE_MODE == 4)) pv_d0(o, vb0 + SHM_V, pa0, pa1, pa2, pa3);
  if (hi == 0) li_l[r32] = l_reg; asm volatile("s_waitcnt lgkmcnt(0)" ::: "memory");
  float rli[16];
#pragma unroll
  for (int r = 0; r < 16; ++r) rli[r] = __builtin_amdgcn_rcpf(li_l[crow(r, hi)]);
  hf* Ow = Ob + (size_t)(wid * 32) * 1024;
#pragma unroll
  for (int r = 0; r < 16; ++r) { const int orow = crow(r, hi);
#pragma unroll
    for (int d0 = 0; d0 < 4; ++d0) Ow[(size_t)orow * 1024 + d0 * 32 + r32] = (hf)(o[d0][r] * rli[r]); }
  __syncthreads();
#undef SLOAD
#undef SWRITE
#undef RESC
}


constexpr int AK_SLOT = 24576, AV_SLOT = 16384, A_RING = 3;
constexpr int A_VOFF = A_RING * AK_SLOT, A_WOFF = A_VOFF + A_RING * AV_SLOT, A_QOFF = A_WOFF + 2048;
template <int OFF> DEV h8v ldsr16(int a) { h8v r; asm volatile("ds_read_b128 %0, %1 offset:%2" : "=&v"(r) : "v"(a), "i"(OFF) : "memory"); return r; }
template <int D0> DEV void qk_issue(h8v& ka, h8v& kbv, const int (&kb)[4]) { ka = ldsr16<(D0 >> 2) * 8192>(kb[D0 & 3]); kbv = ldsr16<(D0 >> 2) * 8192 + 4096>(kb[D0 & 3]); }
template <int D0> DEV void qk_step(f16v& p0, f16v& p1, h8v (&k0)[3], h8v (&k1)[3], const int (&kb)[4], const h8v* qr) {
  if constexpr (D0 + 2 < 12) qk_issue<D0 + 2>(k0[(D0 + 2) % 3], k1[(D0 + 2) % 3], kb);
  constexpr int N = (D0 + 2 < 12) ? 4 : (D0 + 1 < 12 ? 2 : 0);
  asm volatile("s_waitcnt lgkmcnt(%0)" :: "i"(N) : "memory"); SBAR();
  p0 = __builtin_amdgcn_mfma_f32_32x32x16_f16(k0[D0 % 3], qr[D0], p0, 0, 0, 0);
  p1 = __builtin_amdgcn_mfma_f32_32x32x16_f16(k1[D0 % 3], qr[D0], p1, 0, 0, 0);
  SBAR();
}
DEV void qkt2(f16v& p0, f16v& p1, const int (&kb)[4], const h8v* qr, const char*) {
  static_assert(NQL == 0, "qkt2 keeps all twelve q fragments in registers");
#pragma unroll
  for (int r = 0; r < 16; ++r) { p0[r] = 0.f; p1[r] = 0.f; }
  h8v k0[3], k1[3];
  asm volatile("s_waitcnt lgkmcnt(0)" ::: "memory"); SBAR();
  qk_issue<0>(k0[0], k1[0], kb); qk_issue<1>(k0[1], k1[1], kb);
  __builtin_amdgcn_s_setprio(1);
  qk_step<0>(p0, p1, k0, k1, kb, qr); qk_step<1>(p0, p1, k0, k1, kb, qr); qk_step<2>(p0, p1, k0, k1, kb, qr); qk_step<3>(p0, p1, k0, k1, kb, qr);
  qk_step<4>(p0, p1, k0, k1, kb, qr); qk_step<5>(p0, p1, k0, k1, kb, qr); qk_step<6>(p0, p1, k0, k1, kb, qr); qk_step<7>(p0, p1, k0, k1, kb, qr);
  qk_step<8>(p0, p1, k0, k1, kb, qr); qk_step<9>(p0, p1, k0, k1, kb, qr); qk_step<10>(p0, p1, k0, k1, kb, qr); qk_step<11>(p0, p1, k0, k1, kb, qr);
  __builtin_amdgcn_s_setprio(0);
}
DEV unsigned pk2h(float a, float b) { return cvtpk(a, b); }
#define PK4S(P, BASE, OUT) do { unsigned a0 = cvtpk(P[BASE + 0], P[BASE + 1]), a1 = cvtpk(P[BASE + 2], P[BASE + 3]);   \
    unsigned b0 = cvtpk(P[BASE + 4], P[BASE + 5]), b1 = cvtpk(P[BASE + 6], P[BASE + 7]);                              \
    auto r0 = __builtin_amdgcn_permlane32_swap(a0, b0, false, false); auto r1 = __builtin_amdgcn_permlane32_swap(a1, b1, false, false); \
    u4v w = {r0[0], r1[0], r0[1], r1[1]}; OUT = *reinterpret_cast<h8v*>(&w); } while (0)
template <int S> DEV void fsm_slice(f16v& P0, f16v& P1, float& ps, float alpha, float& l_reg, h8v& pa0, h8v& pa1, h8v& pa2, h8v& pa3) {
  if constexpr (S < 8) { P1[2 * S] = __builtin_amdgcn_exp2f(P1[2 * S]); P1[2 * S + 1] = __builtin_amdgcn_exp2f(P1[2 * S + 1]); }
  if constexpr (S == 0) ps = (P0[0] + P0[1]) + (P0[2] + P0[3]);
  if constexpr (S >= 1 && S < 4) ps += (P0[4 * S] + P0[4 * S + 1]) + (P0[4 * S + 2] + P0[4 * S + 3]);
  if constexpr (S == 4 || S == 5) ps += (P1[4 * (S - 4)] + P1[4 * (S - 4) + 1]) + (P1[4 * (S - 4) + 2] + P1[4 * (S - 4) + 3]);
  if constexpr (S == 6) PK4S(P0, 0, pa0);
  if constexpr (S == 7) PK4S(P0, 8, pa1);
  if constexpr (S == 8) { ps += (P1[8] + P1[9]) + (P1[10] + P1[11]); PK4S(P1, 0, pa2); }
  if constexpr (S == 9) { ps += (P1[12] + P1[13]) + (P1[14] + P1[15]); PK4S(P1, 8, pa3); }
  if constexpr (S == 10) { auto rr = __builtin_amdgcn_permlane32_swap(__float_as_uint(ps), __float_as_uint(ps), false, false);
    l_reg = l_reg * alpha + (__uint_as_float(rr[0]) + __uint_as_float(rr[1])); }
}
template <int D0, class DmaF> DEV void qkf_step(f16v& p0, f16v& p1, h8v (&k0)[3], h8v (&k1)[3], const int (&kb)[4], const h8v* qr,
                                    f16v& P0, f16v& P1, float& ps, float alpha, float& l_reg, h8v& pa0, h8v& pa1, h8v& pa2, h8v& pa3, const DmaF& dma) {
  if constexpr (D0 + 2 < 12) qk_issue<D0 + 2>(k0[(D0 + 2) % 3], k1[(D0 + 2) % 3], kb);
  constexpr int N = (D0 + 2 < 12) ? 4 : (D0 + 1 < 12 ? 2 : 0);
  asm volatile("s_waitcnt lgkmcnt(%0)" :: "i"(N) : "memory"); SBAR();
  p0 = __builtin_amdgcn_mfma_f32_32x32x16_f16(k0[D0 % 3], qr[D0], p0, 0, 0, 0);
  SBAR();
  fsm_slice<D0>(P0, P1, ps, alpha, l_reg, pa0, pa1, pa2, pa3);
  SBAR();
  p1 = __builtin_amdgcn_mfma_f32_32x32x16_f16(k1[D0 % 3], qr[D0], p1, 0, 0, 0);
  SBAR();
  if constexpr (D0 >= 1 && D0 <= 5) { dma(D0 - 1); SBAR(); }
}
template <class DmaF> DEV void qk_fsm(f16v& p0, f16v& p1, const int (&kb)[4], const h8v* qr, f16v& P0, f16v& P1, float alpha, float& l_reg, h8v& pa0, h8v& pa1, h8v& pa2, h8v& pa3, const DmaF& dma) {
#pragma unroll
  for (int r = 0; r < 16; ++r) { p0[r] = 0.f; p1[r] = 0.f; }
  h8v k0[3], k1[3]; float ps = 0.f;
  asm volatile("s_waitcnt lgkmcnt(0)" ::: "memory"); SBAR();
  qk_issue<0>(k0[0], k1[0], kb); qk_issue<1>(k0[1], k1[1], kb);
#define QKF(D) qkf_step<D>(p0, p1, k0, k1, kb, qr, P0, P1, ps, alpha, l_reg, pa0, pa1, pa2, pa3, dma)
  QKF(0); QKF(1); QKF(2); QKF(3); QKF(4); QKF(5); QKF(6); QKF(7); QKF(8); QKF(9); QKF(10); QKF(11);
#undef QKF
}
DEV void attn_body_dma(const hf* __restrict__ Qb, const hf* __restrict__ Kh, const hf* __restrict__ Rh, const hf* __restrict__ Vh, hf* __restrict__ Ob, int seq, char* lds, bool dry) {
  const int tid = get_tid(), wid = tid >> 6, lane = tid & 63, r32 = lane & 31, hi = lane >> 5;
  float* wsm = (float*)(lds + A_WOFF) + wid * 64; float* li_l = wsm; float* al_l = wsm + 32;
  float m_reg = -1e30f, l_reg = 0.f; f16v o[4]; h8v qr[12 - NQL];
  char* qrl = lds + A_QOFF + wid * (NQL * 1024) + lane * 16;
#pragma unroll
  for (int d = 0; d < 4; ++d)
#pragma unroll
    for (int r = 0; r < 16; ++r) o[d][r] = 0.f;
  const hf* Qw = Qb + (size_t)(wid * 32 + r32) * DK + hi * 8;
#pragma unroll
  for (int d0 = 0; d0 < 12 - NQL; ++d0) qr[d0] = *(const h8v*)(Qw + d0 * 16);
#pragma unroll
  for (int d0 = 12 - NQL; d0 < 12; ++d0) *(h8v*)(qrl + (d0 - (12 - NQL)) * 1024) = *(const h8v*)(Qw + d0 * 16);
  const hf *sk0, *sk1, *sk2, *sv0, *sv1;
  { const int row = 8 * wid + (lane >> 3), c = (lane & 7) ^ ((row >> 1) & 7);
    sk0 = Kh + (size_t)row * 128 + c * 8; sk1 = sk0 + 64; sk2 = Rh + (size_t)row * 64 + c * 8;
    const int st0 = 4 * wid + (lane >> 5), st1 = st0 + 2;
    const int kk0 = (st0 >> 2) * 8 + ((lane & 31) >> 2), kk1 = (st1 >> 2) * 8 + ((lane & 31) >> 2);
    const int k0_ = (kk0 & ~0xC) | ((kk0 & 4) << 1) | ((kk0 & 8) >> 1), k1_ = (kk1 & ~0xC) | ((kk1 & 4) << 1) | ((kk1 & 8) >> 1);
    sv0 = Vh + (size_t)k0_ * 128 + (st0 & 3) * 32 + (lane & 3) * 8; sv1 = Vh + (size_t)k1_ * 128 + (st1 & 3) * 32 + (lane & 3) * 8; }
  char* kdst = lds + wid * 1024; char* vdst = lds + A_VOFF + wid * 2048;
#define A_DMA(slot, t) do { if (dry && PROBE_MODE == 6) break; const size_t ko_ = (size_t)(t) * 64; char* kd_ = kdst + (slot) * AK_SLOT; char* vd_ = vdst + (slot) * AV_SLOT;         \
    glds16(sk0 + ko_ * 128, kd_); glds16(sk1 + ko_ * 128, kd_ + 8192); glds16(sk2 + ko_ * 64, kd_ + 16384); glds16(sv0 + ko_ * 128, vd_); glds16(sv1 + ko_ * 128, vd_ + 1024); } while (0)
  int ko4[4];
#pragma unroll
  for (int j = 0; j < 4; ++j) ko4[j] = (int)(uintptr_t)lds + r32 * 128 + (((2 * j + hi) ^ ((r32 >> 1) & 7)) << 4);
  const int vb0 = (int)(uintptr_t)lds + A_VOFF + v_rd_base(lane);
#define RESC2(a) do { if (__any((a) < 1.f)) { if (hi == 0) al_l[r32] = (a); asm volatile("s_waitcnt lgkmcnt(0)" ::: "memory"); \
    _Pragma("unroll") for (int d = 0; d < 4; ++d) _Pragma("unroll") for (int r = 0; r < 16; ++r) o[d][r] *= al_l[crow(r, hi)]; } } while (0)
#define A_KB(slot) do { _Pragma("unroll") for (int j = 0; j < 4; ++j) kb[j] = ko4[j] + (slot) * AK_SLOT; } while (0)
#define A_NEXT(s_) ((s_) == 2 ? 0 : (s_) + 1)
  f16v pA0, pA1, pB0, pB1; float mnA, mnB, alA, alB; h8v pa0, pa1, pa2, pa3; const int NT = seq / 64;
  int kb[4];
  int dt = -1, dsl = 0;
  auto dma_piece = [&](int i) { if (dt < 0 || (dry && PROBE_MODE == 6)) return; const size_t ko_ = (size_t)dt * 64; char* kd_ = kdst + dsl * AK_SLOT; char* vd_ = vdst + dsl * AV_SLOT;
    if (i == 0) glds16(sk0 + ko_ * 128, kd_); else if (i == 1) glds16(sk1 + ko_ * 128, kd_ + 8192); else if (i == 2) glds16(sk2 + ko_ * 64, kd_ + 16384);
    else if (i == 3) glds16(sv0 + ko_ * 128, vd_); else glds16(sv1 + ko_ * 128, vd_ + 1024); };
  A_DMA(0, 0); A_DMA(1, 1);
  __syncthreads();
  A_KB(0); qkt2(pA0, pA1, kb, qr, qrl); partialSM(pA0, pA1, m_reg, mnA, alA, dry);
  if (2 < NT) { dt = 2; dsl = 2; }
  int sc = 1;
  for (int j = 1; j + 1 < NT; j += 2) {
    { const int sp = sc == 0 ? 2 : sc - 1;
      SBAR(); A_KB(sc); qk_fsm(pB0, pB1, kb, qr, pA0, pA1, alA, l_reg, pa0, pa1, pa2, pa3, dma_piece); SBAR();
      if (!(dry && PROBE_MODE == 4)) pv_d0(o, vb0 + sp * AV_SLOT, pa0, pa1, pa2, pa3);
      partialSM(pB0, pB1, m_reg, mnB, alB, dry);
      __syncthreads();
      dt = (j + 2 < NT) ? j + 2 : -1; dsl = sp;
      RESC2(alB); sc = A_NEXT(sc); }
    { const int sp = sc == 0 ? 2 : sc - 1;
      SBAR(); A_KB(sc); qk_fsm(pA0, pA1, kb, qr, pB0, pB1, alB, l_reg, pa0, pa1, pa2, pa3, dma_piece); SBAR();
      if (!(dry && PROBE_MODE == 4)) pv_d0(o, vb0 + sp * AV_SLOT, pa0, pa1, pa2, pa3);
      partialSM(pA0, pA1, m_reg, mnA, alA, dry);
      __syncthreads();
      dt = (j + 3 < NT) ? j + 3 : -1; dsl = sp;
      RESC2(alA); sc = A_NEXT(sc); }
  }
  { const int sp = sc == 0 ? 2 : sc - 1;
    SBAR(); A_KB(sc); qk_fsm(pB0, pB1, kb, qr, pA0, pA1, alA, l_reg, pa0, pa1, pa2, pa3, dma_piece); SBAR();
    if (!(dry && PROBE_MODE == 4)) pv_d0(o, vb0 + sp * AV_SLOT, pa0, pa1, pa2, pa3);
    partialSM(pB0, pB1, m_reg, mnB, alB, dry);
    RESC2(alB);
    finishSM(pB0, pB1, alB, l_reg, pa0, pa1, pa2, pa3, dry); SBAR();
    if (!(dry && PROBE_MODE == 4)) pv_d0(o, vb0 + sc * AV_SLOT, pa0, pa1, pa2, pa3); }
  if (hi == 0) li_l[r32] = l_reg; asm volatile("s_waitcnt lgkmcnt(0)" ::: "memory");
  float rli[16];
#pragma unroll
  for (int r = 0; r < 16; ++r) rli[r] = __builtin_amdgcn_rcpf(li_l[crow(r, hi)]);
  hf* Ow = Ob + (size_t)(wid * 32) * 1024;
#pragma unroll
  for (int r = 0; r < 16; ++r) { const int orow = crow(r, hi);
#pragma unroll
    for (int d0 = 0; d0 < 4; ++d0) Ow[(size_t)orow * 1024 + d0 * 32 + r32] = (hf)(o[d0][r] * rli[r]); }
  __syncthreads();
#undef A_DMA
#undef RESC2
#undef A_KB
#undef A_NEXT
}

PHASE void attn_phase(PP p, bool with_ctx, char* lds, int bid, int nblk, bool dry) {
  const hf* Q = (const hf*)(p->ws + OFF_Q); const hf* Qc = (const hf*)(p->ws + OFF_QC);
  const hf* Kb = (const hf*)(p->ws + OFF_K); const hf* KR = (const hf*)(p->ws + OFF_KR); const hf* Vb = (const hf*)(p->ws + OFF_V); hf* O = (hf*)(p->ws + OFF_ATT);
  const int nx = NB * NH * (SEQ / 256), nitems = nx + (with_ctx ? NB * NH : 0);
  for (int it = bid; it < nitems; it += nblk) {
    const bool isx = it < nx;
    const int rnd = it >> 8, w = it & 255;
    const int bh = isx ? (w & 7) + 8 * rnd : it - nx, qb = isx ? (w >> 3) : 0;
    const int b = bh >> 3, h = bh & 7, koff = isx ? 0 : SEQ, seq = isx ? TKV : CTXL;
    const hf* Qp = isx ? Q + ((size_t)bh * SEQ + qb * 256) * DK : Qc + (size_t)bh * CTXL * DK;
    const size_t orow = isx ? (size_t)(b * SEQ + qb * 256) : (size_t)(NTOK + b * CTXL);
    if (dry) O = (hf*)(p->ws + OFF_PD);
    attn_body_dma(Qp, Kb + ((size_t)bh * TKV + koff) * 128, KR + ((size_t)b * TKV + koff) * 64, Vb + ((size_t)bh * TKV + koff) * DV, O + orow * 1024 + h * DV, seq, lds, dry);
  }
}

DEV void ln_row(float (&v)[16], int lane, const float* lg, const float* lb, float* xo, hf* xh, hf* ho, const float* sc, const float* sh) {
  float s = 0.f;
#pragma unroll
  for (int i = 0; i < 16; ++i) s += v[i];
  const float mean = wave_sum(s) * (1.f / 1024.f);
  float q = 0.f;
#pragma unroll
  for (int i = 0; i < 16; ++i) { const float d = v[i] - mean; q += d * d; }
  const float rstd = rsqrtf(wave_sum(q) * (1.f / 1024.f) + LN_EPS);
#pragma unroll
  for (int hh = 0; hh < 2; ++hh) {
    const int c0 = hh * 512 + lane * 8;
    float xn[8];
#pragma unroll
    for (int i = 0; i < 8; ++i) xn[i] = (v[hh * 8 + i] - mean) * rstd * lg[c0 + i] + lb[c0 + i];
    if (xo) { *(f4v*)(xo + c0) = (f4v){xn[0], xn[1], xn[2], xn[3]}; *(f4v*)(xo + c0 + 4) = (f4v){xn[4], xn[5], xn[6], xn[7]}; }
    if (xh) { h8v t;
#pragma unroll
      for (int i = 0; i < 8; ++i) t[i] = (hf)xn[i];
      *(h8v*)(xh + c0) = t; }
    if (ho) { h8v t;
#pragma unroll
      for (int i = 0; i < 8; ++i) t[i] = (hf)(xn[i] * (1.f + sc[c0 + i]) + sh[c0 + i]);
      *(h8v*)(ho + c0) = t; }
  }
}
DEV const float* modp(PP p, int layer, int row, int chunk) { const int mi = row < NTOK ? (row >> 13) : 2; return (const float*)(p->ws + OFF_MOD) + ((size_t)(layer * 3 + mi) * 6 + chunk) * 1024; }

PHASE void ln_phase(PP p, int layer, int which, int M, int bid, int nblk, bool dry) {
  const int wid = get_tid() >> 6, lane = get_tid() & 63;
  hf* X = (hf*)(p->ws + OFF_X); const hf* Y = (const hf*)(p->ws + OFF_Y); hf* H = (hf*)(p->ws + OFF_H);
  const float* lg = p->in[I_LNG] + (size_t)(layer * 2 + which) * 1024; const float* lb = p->in[I_LNB] + (size_t)(layer * 2 + which) * 1024;
  const bool last = which == 1 && layer == DEPTH - 1;
  const int rstep = nblk * 8;
  for (int row0 = bid * 8 + wid; row0 < M; row0 += 2 * rstep) {
    const int row1 = row0 + rstep; const bool has1 = row1 < M; const int r1 = has1 ? row1 : row0;
    h8v xv[2][2], yv[2][2];
#pragma unroll
    for (int hh = 0; hh < 2; ++hh) { const int c0 = hh * 512 + lane * 8;
      xv[0][hh] = *(const h8v*)(X + (size_t)row0 * 1024 + c0); yv[0][hh] = *(const h8v*)(Y + (size_t)row0 * 1024 + c0);
      xv[1][hh] = *(const h8v*)(X + (size_t)r1 * 1024 + c0); yv[1][hh] = *(const h8v*)(Y + (size_t)r1 * 1024 + c0); }
#pragma unroll
    for (int k = 0; k < 2; ++k) {
      const int row = k ? row1 : row0;
      if (k == 1 && !has1) break;
      const float* gate = modp(p, layer, row, which ? 5 : 2);
      const float* shn = which ? modp(p, last ? layer : layer + 1, row, 0) : modp(p, layer, row, 3);
      const float* scn = which ? modp(p, last ? layer : layer + 1, row, 1) : modp(p, layer, row, 4);
      float v[16];
#pragma unroll
      for (int hh = 0; hh < 2; ++hh) { const int c0 = hh * 512 + lane * 8;
#pragma unroll
        for (int i = 0; i < 8; ++i) v[hh * 8 + i] = ALPHA * (float)xv[k][hh][i] + gate[c0 + i] * (float)yv[k][hh][i]; }
      float* xo = (last && !dry) ? p->out + (size_t)row * 1024 : (float*)nullptr;
      hf* xh = dry ? (hf*)(p->ws + OFF_PD) + (size_t)row * 1024 : (last ? (hf*)nullptr : X + (size_t)row * 1024);
      hf* ho = dry ? (hf*)(p->ws + OFF_Z) + (size_t)row * 1024 : (last ? (hf*)nullptr : H + (size_t)row * 1024);
      ln_row(v, lane, lg, lb, xo, xh, ho, scn, shn);
    }
  }
}

PHASE void pool_phase(PP p, int M, int bid, int nblk) {
  const hf* Z = (const hf*)(p->ws + OFF_Z); hf* P = (hf*)(p->ws + OFF_ATT);
  const long total = (long)(M / 16) * 128;
  for (long idx = (long)bid * NTHR + get_tid(); idx < total; idx += (long)nblk * NTHR) {
    const int run = (int)(idx >> 7), ch = (int)(idx & 127), g = ch >> 5, half = 1 << g;
    const int row0 = run * 16;
    int base, L, t0;
    if (row0 < NTOK) { base = row0 & ~8191; L = SEQ; t0 = row0 & 8191; } else { const int rr = row0 - NTOK; base = NTOK + (rr & ~255); L = CTXL; t0 = rr & 255; }
    const hf* Zc = Z + (size_t)base * 1024 + ch * 8;
    float s[8] = {0, 0, 0, 0, 0, 0, 0, 0};
    { const int lo = max(t0 - half, 0), hi = min(t0 + half, L);
      for (int u = lo; u < hi; ++u) { const h8v z = *(const h8v*)(Zc + (size_t)u * 1024);
#pragma unroll
        for (int i = 0; i < 8; ++i) s[i] += (float)z[i]; } }
#pragma unroll 4
    for (int k = 0; k < 16; ++k) {
      const int t = t0 + k, lo = max(t - half, 0), hi = min(t + half, L);
      const h8v zs = *(const h8v*)(Zc + (size_t)t * 1024); const float inv = 1.f / (float)(hi - lo);
      h8v o;
#pragma unroll
      for (int i = 0; i < 8; ++i) o[i] = (hf)(s[i] * inv - (float)zs[i]);
      *(h8v*)(P + (size_t)(base + t) * 1024 + ch * 8) = o;
      if (k < 15) {
        if (t + half < L) { const h8v z = *(const h8v*)(Zc + (size_t)(t + half) * 1024);
#pragma unroll
          for (int i = 0; i < 8; ++i) s[i] += (float)z[i]; }
        if (t - half >= 0) { const h8v z = *(const h8v*)(Zc + (size_t)(t - half) * 1024);
#pragma unroll
          for (int i = 0; i < 8; ++i) s[i] -= (float)z[i]; }
      }
    }
  }
}

DEV unsigned pack_key(float f, unsigned id, unsigned mask) { const unsigned u = __float_as_uint(f); const unsigned m = u ^ ((u & 0x80000000u) ? 0xFFFFFFFFu : 0x80000000u); return (m & ~mask) | id; }
DEV float unpack_val(unsigned key, unsigned mask) { const unsigned m = key & ~mask; const unsigned u = (m & 0x80000000u) ? (m ^ 0x80000000u) : ~m; return __uint_as_float(u); }
DEV void cas(unsigned& a, unsigned& b) { const unsigned mx = a > b ? a : b, mn = a > b ? b : a; a = mx; b = mn; }
template <int N> DEV void bitonic_sort_desc(unsigned (&k)[N]) {
#pragma unroll
  for (int size = 2; size <= N; size <<= 1)
#pragma unroll
    for (int stride = size >> 1; stride > 0; stride >>= 1)
#pragma unroll
      for (int i = 0; i < N; ++i) { const int j = i ^ stride; if (j > i) { if ((i & size) == 0) cas(k[i], k[j]); else cas(k[j], k[i]); } }
}
DEV void bitonic_merge16(unsigned (&k)[16]) {
#pragma unroll
  for (int stride = 8; stride > 0; stride >>= 1)
#pragma unroll
    for (int i = 0; i < 16; ++i) { const int j = i ^ stride; if (j > i) cas(k[i], k[j]); }
}
DEV void merge_top16(unsigned (&a)[16], const unsigned (&b)[16]) {
#pragma unroll
  for (int i = 0; i < 16; ++i) { const unsigned y = b[15 - i]; a[i] = a[i] > y ? a[i] : y; }
  bitonic_merge16(a);
}
DEV void local_top16(const f16v (&acc)[4], int hi, unsigned (&outk)[16]) {
  unsigned g[16], t[16];
#pragma unroll
  for (int mt = 0; mt < 4; ++mt) {
#pragma unroll
    for (int r = 0; r < 16; ++r) t[r] = pack_key(acc[mt][r], (unsigned)(mt * 32 + (r & 3) + 8 * (r >> 2) + 4 * hi), 0x7Fu);
    bitonic_sort_desc<16>(t);
    if (mt == 0) {
#pragma unroll
      for (int r = 0; r < 16; ++r) g[r] = t[r];
    } else merge_top16(g, t);
  }
#pragma unroll
  for (int r = 0; r < 16; ++r) outk[r] = g[r];
}

PHASE void topk_phase(PP p, int layer, int M, char* lds, int bid, int nblk) {
  const int tid = get_tid(), wid = tid >> 6, lane = tid & 63, r32 = lane & 31, hi = lane >> 5;
  const hf* PQ = (const hf*)(p->ws + OFF_PQ);
  unsigned short* IDX = (unsigned short*)(p->ws + OFF_IDX); float* G = (float*)(p->ws + OFF_G);
  const int h = bid & 7, nper = nblk >> 3;
  char* Klds = lds;
  unsigned char* lut = (unsigned char*)lds + 65536 + wid * 2048 + lane * 32;
  if (bid < nper * 8) {
#pragma unroll
    for (int half = 0; half < 2; ++half) {
      const hf* Kg = (const hf*)(p->ws + (half ? OFF_K2 : OFF_K1)) + ((size_t)(layer * NH + h) * 128) * 128;
#pragma unroll
      for (int q = 0; q < 4; ++q) { const int cidx = tid + q * NTHR, row = cidx >> 4, ch = cidx & 15;
        *(h8v*)(Klds + half * 32768 + row * 256 + ((ch ^ (row & 15)) << 4)) = *(const h8v*)(Kg + (size_t)row * 128 + ch * 8); }
    }
  }
  __syncthreads();
  for (int mt256 = bid >> 3; mt256 < M / 256 && bid < nper * 8; mt256 += nper) {
    const int token = mt256 * 256 + wid * 32 + r32;
    unsigned A1[16], A2[16];
#pragma unroll
    for (int half = 0; half < 2; ++half) {
      f16v acc[4];
#pragma unroll
      for (int m = 0; m < 4; ++m)
#pragma unroll
        for (int r = 0; r < 16; ++r) acc[m][r] = 0.f;
      const hf* qp = PQ + (size_t)token * 2048 + h * 256 + half * 128 + hi * 8;
      h8v bq[8];
#pragma unroll
      for (int ks = 0; ks < 8; ++ks) bq[ks] = *(const h8v*)(qp + ks * 16);
#pragma unroll
      for (int ks = 0; ks < 8; ++ks) {
#pragma unroll
        for (int m = 0; m < 4; ++m) {
          const int row = m * 32 + r32;
          const h8v ak = *(const h8v*)(Klds + half * 32768 + row * 256 + (((ks * 2 + hi) ^ (row & 15)) << 4));
          acc[m] = __builtin_amdgcn_mfma_f32_32x32x16_f16(ak, bq[ks], acc[m], 0, 0, 0);
        }
      }
      if (half == 0) local_top16(acc, hi, A1); else local_top16(acc, hi, A2);
    }
    unsigned L[16];
    {
      unsigned Bq[16];
#pragma unroll
      for (int i = 0; i < 16; ++i) { auto rr = __builtin_amdgcn_permlane32_swap(A1[i], A2[i], false, false); L[i] = rr[0]; Bq[i] = rr[1]; }
      merge_top16(L, Bq);
    }
    float f1[16], f2[16];
    {
      unsigned pk1 = 0, pk2 = 0, w1[4], w2[4];
#pragma unroll
      for (int i = 0; i < 16; ++i) {
        auto rr = __builtin_amdgcn_permlane32_swap(L[i], L[i], false, false);
        const unsigned k1 = rr[0], k2 = rr[1];
        f1[i] = unpack_val(k1, 0x7Fu); f2[i] = unpack_val(k2, 0x7Fu);
        pk1 |= (k1 & 0x7Fu) << (8 * (i & 3)); pk2 |= (k2 & 0x7Fu) << (8 * (i & 3));
        if ((i & 3) == 3) { w1[i >> 2] = pk1; w2[i >> 2] = pk2; pk1 = 0; pk2 = 0; }
      }
      *(u4v*)(lut) = (u4v){w1[0], w1[1], w1[2], w1[3]}; *(u4v*)(lut + 16) = (u4v){w2[0], w2[1], w2[2], w2[3]};
    }
    unsigned c[64];
    {
      int n = 0;
#pragma unroll
      for (int a = 0; a < 16; ++a)
#pragma unroll
        for (int b = 0; b < 16; ++b) if ((a + 1) * (b + 1) <= 16) { c[n] = pack_key(f1[a] + f2[b], (unsigned)(a * 16 + b), 0xFFu); ++n; }
#pragma unroll
      for (int i = 50; i < 64; ++i) c[i] = 0u;
    }
    unsigned T[16];
    {
      unsigned t[16];
#pragma unroll
      for (int grp = 0; grp < 4; ++grp) {
#pragma unroll
        for (int r = 0; r < 16; ++r) t[r] = c[grp * 16 + r];
        bitonic_sort_desc<16>(t);
        if (grp == 0) {
#pragma unroll
          for (int r = 0; r < 16; ++r) T[r] = t[r];
        } else merge_top16(T, t);
      }
    }
    float sv[16]; const float mx = unpack_val(T[0], 0xFFu); float den = 0.f;
#pragma unroll
    for (int i = 0; i < 16; ++i) { sv[i] = __expf(unpack_val(T[i], 0xFFu) - mx); den += sv[i]; }
    const float rden = 1.f / den;
    asm volatile("s_waitcnt lgkmcnt(0)" ::: "memory");
    if (hi == 0) {
      unsigned short* ip = IDX + (size_t)token * 128 + h * 16; float* gp = G + (size_t)token * 128 + h * 16;
#pragma unroll
      for (int i = 0; i < 16; ++i) {
        const unsigned id = T[i] & 0xFFu; const int a = id >> 4, b = id & 15;
        const int i1 = lut[a], i2 = lut[16 + b];
        ip[i] = (unsigned short)(i1 * 128 + i2); gp[i] = sv[i] * rden;
      }
    }
  }
}

DEV float gelu_exact(float x) { return 0.5f * x * (1.f + erff(x * 0.7071067811865476f)); }

struct XRole { int lx, nlx, rank, cnt; };
constexpr int CTL_WORDS = 8;
#define LAS3 __attribute__((address_space(3)))
DEV XRole get_role(PP p, char* lds, int bid, int nblk, bool one_launch) {
  XRole r;
  if (!one_launch) { r.lx = bid & 7; r.nlx = 8; r.rank = bid >> 3; r.cnt = (nblk + 7 - (bid & 7)) >> 3; return r; }
  volatile LAS3 unsigned* st = (volatile LAS3 unsigned*)(lds + LDS_TOTAL);
  if (__builtin_amdgcn_workitem_id_x() == 0 && st[7] == 0u) {
    unsigned* bar = (unsigned*)(p->ws + OFF_BAR); const unsigned x = st[3];
    unsigned lx = 0, nlx = 0, cnt = 1;
    for (unsigned j = 0; j < 16; ++j) { const unsigned c = __hip_atomic_load(&bar[256 + 64 * j], __ATOMIC_RELAXED, __HIP_MEMORY_SCOPE_AGENT); if (c > 0u) { if (j < x) ++lx; ++nlx; } if (j == x) cnt = c > 0u ? c : 1u; }
    st[4] = lx; st[5] = nlx > 0u ? nlx : 1u; st[6] = cnt; st[7] = 1u;
  }
  __syncthreads();
  r.lx = __builtin_amdgcn_readfirstlane((int)st[4]); r.nlx = __builtin_amdgcn_readfirstlane((int)st[5]); r.cnt = __builtin_amdgcn_readfirstlane((int)st[6]); r.rank = __builtin_amdgcn_readfirstlane((int)st[2]);
  return r;
}
DEV void fp8x16_to_f32(u4v d, float (&o)[16]) {
#pragma unroll
  for (int q = 0; q < 4; ++q) { const f2v lo = __builtin_amdgcn_cvt_pk_f32_fp8((int)d[q], false), hi = __builtin_amdgcn_cvt_pk_f32_fp8((int)d[q], true); o[4 * q] = lo[0]; o[4 * q + 1] = lo[1]; o[4 * q + 2] = hi[0]; o[4 * q + 3] = hi[1]; }
}
DEV void* uniform_ptr(const void* q) { const unsigned long long b = (unsigned long long)q; const unsigned lo = __builtin_amdgcn_readfirstlane((unsigned)b), hi = __builtin_amdgcn_readfirstlane((unsigned)(b >> 32)); return (void*)(((unsigned long long)hi << 32) | lo); }
template <int CTRL> DEV float dpp_mov(float v) { return __builtin_bit_cast(float, __builtin_amdgcn_update_dpp(0, __builtin_bit_cast(int, v), CTRL, 0xF, 0xF, true)); }
PHASE void peer_u_phase(PP p, int layer, int M, const XRole r, int bid, int nblk) {
  const int tid = get_tid(), wid = tid >> 6, lane = tid & 63, g = lane >> 3, c = lane & 7;
  const hf* H = (const hf*)(p->ws + OFF_H); const unsigned short* IDX = (const unsigned short*)(p->ws + OFF_IDX);
  const int t0 = r.rank * 8 + wid, step = r.cnt * 8;
  const int slot_out = g * 16 + ((c & 4) ? 8 : 0) + ((c & 1) ? 4 : 0) + ((c & 2) ? 2 : 0);
  for (int s = r.lx; s < 8; s += r.nlx) {
    const __amdgpu_buffer_rsrc_t rs = __builtin_amdgcn_make_buffer_rsrc(uniform_ptr(p->ws + OFF_U8 + ((size_t)(layer * 8 + s) * NEXP) * 128), 0, NEXP * 128, 0x00020000);
    hf* PDs = (hf*)(p->ws + OFF_PD) + (size_t)s * MALL * 128 + slot_out;
    const hf* Hs = H + s * 128 + c * 16;
    int eA[16]; u4v dA[16], dB[16]; h8v hA0, hA1, hB0, hB1;
#define U_LOADE(E, tok) do { const u4v* ip_ = (const u4v*)(IDX + (size_t)(tok) * 128 + g * 16); _Pragma("unroll") for (int q = 0; q < 2; ++q) { const u4v t_ = ip_[q]; _Pragma("unroll") for (int k = 0; k < 4; ++k) { E[8 * q + 2 * k] = (int)(t_[k] & 0xFFFFu); E[8 * q + 2 * k + 1] = (int)(t_[k] >> 16); } } } while (0)
#define U_ISSUE(D, E, H0, H1, tok) do { _Pragma("unroll") for (int i = 0; i < 16; ++i) D[i] = __builtin_amdgcn_raw_buffer_load_b128(rs, E[i] * 128 + c * 16, 0, 0); \
    H0 = *(const h8v*)(Hs + (size_t)(tok) * 1024); H1 = *(const h8v*)(Hs + (size_t)(tok) * 1024 + 8); } while (0)
#define U_COMPUTE(D, H0, H1, tok) do { const h2v* hp0_ = (const h2v*)&H0; const h2v* hp1_ = (const h2v*)&H1; float pd[16];                        \
    _Pragma("unroll") for (int i = 0; i < 16; ++i) { float a = 0.f;                                                                                  \
      _Pragma("unroll") for (int q = 0; q < 4; ++q) { const int dw = (int)D[i][q];                                                                   \
        a = __builtin_amdgcn_fdot2(__builtin_amdgcn_cvt_scalef32_pk_f16_fp8(dw, 1.0f, false), q < 2 ? hp0_[2 * q] : hp1_[2 * q - 4], a, false);     \
        a = __builtin_amdgcn_fdot2(__builtin_amdgcn_cvt_scalef32_pk_f16_fp8(dw, 1.0f, true), q < 2 ? hp0_[2 * q + 1] : hp1_[2 * q - 3], a, false); } \
      pd[i] = a; }                                                                                                                                    \
    float r8[8], r4[4], r2[2];                                                                                                                        \
    _Pragma("unroll") for (int k = 0; k < 8; ++k) { const float keep = (c & 4) ? pd[8 + k] : pd[k], send = (c & 4) ? pd[k] : pd[8 + k]; r8[k] = keep + dpp_mov<0x141>(send); } \
    _Pragma("unroll") for (int k = 0; k < 4; ++k) { const float keep = (c & 1) ? r8[4 + k] : r8[k], send = (c & 1) ? r8[k] : r8[4 + k]; r4[k] = keep + dpp_mov<0xB1>(send); }  \
    _Pragma("unroll") for (int k = 0; k < 2; ++k) { const float keep = (c & 2) ? r4[2 + k] : r4[k], send = (c & 2) ? r4[k] : r4[2 + k]; r2[k] = keep + dpp_mov<0x4E>(send); }  \
    h2v pdo_; pdo_[0] = (hf)(r2[0] * 0.0625f); pdo_[1] = (hf)(r2[1] * 0.0625f); *(h2v*)(PDs + (size_t)(tok) * 128) = pdo_; } while (0)
    if (t0 < M) { U_LOADE(eA, t0); U_ISSUE(dA, eA, hA0, hA1, t0); }
    if (t0 + step < M) U_LOADE(eA, t0 + step);
    for (int token = t0; token < M; token += 2 * step) {
      if (token + step < M) U_ISSUE(dB, eA, hB0, hB1, token + step);
      if (token + 2 * step < M) U_LOADE(eA, token + 2 * step);
      U_COMPUTE(dA, hA0, hA1, token);
      if (token + step >= M) break;
      if (token + 2 * step < M) U_ISSUE(dA, eA, hA0, hA1, token + 2 * step);
      if (token + 3 * step < M) U_LOADE(eA, token + 3 * step);
      U_COMPUTE(dB, hB0, hB1, token + step);
    }
#undef U_LOADE
#undef U_ISSUE
#undef U_COMPUTE
  }
}
PHASE void peer_w_phase(PP p, int layer, int M, int bid, int nblk) {
  const hf* PD = (const hf*)(p->ws + OFF_PD); const unsigned short* IDX = (const unsigned short*)(p->ws + OFF_IDX); const float* G = (const float*)(p->ws + OFF_G);
  const float* SU = (const float*)(p->ws + OFF_SU) + (size_t)layer * NEXP; const float* SV = (const float*)(p->ws + OFF_SV) + (size_t)layer * NEXP;
  hf* W = (hf*)(p->ws + OFF_W);
  const long total = (long)M * 128 / 8;
  for (long i8 = (long)bid * NTHR + get_tid(); i8 < total; i8 += (long)nblk * NTHR) {
    const long i = i8 * 8;
    float s[8] = {0, 0, 0, 0, 0, 0, 0, 0};
#pragma unroll
    for (int k = 0; k < 8; ++k) { const h8v v = *(const h8v*)(PD + (size_t)k * MALL * 128 + i);
#pragma unroll
      for (int j = 0; j < 8; ++j) s[j] += (float)v[j]; }
    const u4v ev = *(const u4v*)(IDX + i); const f4v g0 = *(const f4v*)(G + i), g1 = *(const f4v*)(G + i + 4);
    h8v w;
#pragma unroll
    for (int j = 0; j < 8; ++j) { const int e = (int)((ev[j >> 1] >> (16 * (j & 1))) & 0xFFFFu); const float g = j < 4 ? g0[j & 3] : g1[j & 3]; w[j] = (hf)(g * gelu_exact(SU[e] * 16.f * s[j]) * SV[e] * 256.f); }
    *(h8v*)(W + i) = w;
  }
}
PHASE void peer_v_phase(PP p, int layer, int M, const XRole r, int bid, int nblk) {
  const int tid = get_tid(), wid = tid >> 6, lane = tid & 63, g = lane >> 3, c = lane & 7;
  const unsigned short* IDX = (const unsigned short*)(p->ws + OFF_IDX); const hf* W = (const hf*)(p->ws + OFF_W);
  const int t0 = r.rank * 8 + wid, step = r.cnt * 8;
  for (int s = r.lx; s < 8; s += r.nlx) {
    const __amdgpu_buffer_rsrc_t rs = __builtin_amdgcn_make_buffer_rsrc(uniform_ptr(p->ws + OFF_V8 + ((size_t)(layer * 8 + s) * NEXP) * 128), 0, NEXP * 128, 0x00020000);
    hf* OUTs = (hf*)(p->ws + OFF_Y) + s * 128 + c * 16 + 2 * g;
    int eA[16]; u4v dA[16], dB[16]; float wA[16], wB[16];
#define V_LOADE(E, tok) do { const u4v* ip_ = (const u4v*)(IDX + (size_t)(tok) * 128 + g * 16); _Pragma("unroll") for (int q = 0; q < 2; ++q) { const u4v t_ = ip_[q]; _Pragma("unroll") for (int k = 0; k < 4; ++k) { E[8 * q + 2 * k] = (int)(t_[k] & 0xFFFFu); E[8 * q + 2 * k + 1] = (int)(t_[k] >> 16); } } } while (0)
#define V_ISSUE(D, E, WW, tok) do { _Pragma("unroll") for (int i = 0; i < 16; ++i) D[i] = __builtin_amdgcn_raw_buffer_load_b128(rs, E[i] * 128 + c * 16, 0, 0); \
    const h8v* wp_ = (const h8v*)(W + (size_t)(tok) * 128 + g * 16); _Pragma("unroll") for (int q = 0; q < 2; ++q) { const h8v u_ = wp_[q]; _Pragma("unroll") for (int k = 0; k < 8; ++k) WW[8 * q + k] = (float)u_[k]; } } while (0)
#define V_COMPUTE(D, WW, tok) do { h2v ah[8];                                                                                                      \
    _Pragma("unroll") for (int j = 0; j < 8; ++j) { ah[j][0] = (hf)0.f; ah[j][1] = (hf)0.f; }                                                         \
    _Pragma("unroll") for (int i = 0; i < 16; ++i) { h2v w2_; w2_[0] = (hf)WW[i]; w2_[1] = w2_[0];                                                    \
      _Pragma("unroll") for (int q = 0; q < 4; ++q) { const int dw_ = (int)D[i][q];                                                                   \
        { const auto c_ = __builtin_amdgcn_cvt_scalef32_pk_f16_fp8(dw_, 1.0f, false); ah[2 * q] = __builtin_elementwise_fma(w2_, *(const h2v*)&c_, ah[2 * q]); }                            \
        { const auto c_ = __builtin_amdgcn_cvt_scalef32_pk_f16_fp8(dw_, 1.0f, true); ah[2 * q + 1] = __builtin_elementwise_fma(w2_, *(const h2v*)&c_, ah[2 * q + 1]); } } }                  \
    float acc[16];                                                                                                                                    \
    _Pragma("unroll") for (int j = 0; j < 8; ++j) { acc[2 * j] = (float)ah[j][0] * (1.f / 256.f); acc[2 * j + 1] = (float)ah[j][1] * (1.f / 256.f); } \
    float r8[8], r4[4], r2[2];                                                                                                                        \
    _Pragma("unroll") for (int k = 0; k < 8; ++k) { auto rr = __builtin_amdgcn_permlane32_swap(__float_as_uint(acc[k]), __float_as_uint(acc[8 + k]), false, false); r8[k] = __uint_as_float(rr[0]) + __uint_as_float(rr[1]); } \
    _Pragma("unroll") for (int k = 0; k < 4; ++k) { auto rr = __builtin_amdgcn_permlane16_swap(__float_as_uint(r8[k]), __float_as_uint(r8[4 + k]), false, false); r4[k] = __uint_as_float(rr[0]) + __uint_as_float(rr[1]); }   \
    _Pragma("unroll") for (int k = 0; k < 2; ++k) { const float keep = (g & 1) ? r4[2 + k] : r4[k], send = (g & 1) ? r4[k] : r4[2 + k]; r2[k] = keep + dpp_mov<0x128>(send); }                                                    \
    h2v o_; o_[0] = (hf)r2[0]; o_[1] = (hf)r2[1]; *(h2v*)(OUTs + (size_t)(tok) * 1024) = o_; } while (0)
    if (t0 < M) { V_LOADE(eA, t0); V_ISSUE(dA, eA, wA, t0); }
    if (t0 + step < M) V_LOADE(eA, t0 + step);
    for (int token = t0; token < M; token += 2 * step) {
      if (token + step < M) V_ISSUE(dB, eA, wB, token + step);
      if (token + 2 * step < M) V_LOADE(eA, token + 2 * step);
      V_COMPUTE(dA, wA, token);
      if (token + step >= M) break;
      if (token + 2 * step < M) V_ISSUE(dA, eA, wA, token + 2 * step);
      if (token + 3 * step < M) V_LOADE(eA, token + 3 * step);
      V_COMPUTE(dB, wB, token + step);
    }
#undef V_LOADE
#undef V_ISSUE
#undef V_COMPUTE
  }
}

DEV void transpose_tiles(const TJob j, int tile0, int ntl, char* lds) {
  float* T = (float*)lds;
  const int tid = get_tid();
  const int ntn = j.Npad / 64;
  f4v v[4][2];
#pragma unroll
  for (int q = 0; q < 4; ++q) {
    const int tile = tile0 + (q < ntl ? q : 0), kt = tile / ntn, nt = tile - kt * ntn, k0 = kt * 64, n0 = nt * 64;
#pragma unroll
    for (int jj = 0; jj < 2; ++jj) {
      const int kl = (tid >> 4) + 32 * jj, nl = (tid & 15) * 4;
      v[q][jj] = (f4v){0.f, 0.f, 0.f, 0.f};
      if (q < ntl && n0 + nl < j.N) v[q][jj] = *(const f4v*)(j.src + (size_t)(k0 + kl) * j.N + n0 + nl);
    }
  }
#pragma unroll
  for (int q = 0; q < 4; ++q) {
    const int tile = tile0 + (q < ntl ? q : 0), kt = tile / ntn, k0 = kt * 64;
#pragma unroll
    for (int jj = 0; jj < 2; ++jj) {
      const int kl = (tid >> 4) + 32 * jj, nl = (tid & 15) * 4;
      const float gsc = j.gs ? j.gs[k0 + kl] : 1.f;
#pragma unroll
      for (int i = 0; i < 4; ++i) T[q * 4160 + (nl + i) * 65 + kl] = v[q][jj][i] * gsc;
    }
  }
  __syncthreads();
#pragma unroll
  for (int q = 0; q < 4; ++q) {
    if (q < ntl) {
      const int tile = tile0 + q, kt = tile / ntn, nt = tile - kt * ntn, k0 = kt * 64, n0 = nt * 64;
      const int nl = tid >> 3, kc = (tid & 7) * 8; h8v o;
#pragma unroll
      for (int i = 0; i < 8; ++i) o[i] = (hf)T[q * 4160 + nl * 65 + kc + i];
      *(h8v*)(j.dst + (size_t)(n0 + nl) * j.K + k0 + kc) = o;
    }
  }
  __syncthreads();
}
DEV void convert_f16(const float* __restrict__ src, hf* __restrict__ dst, long n8, int bid, int nblk) {
  for (long i = (long)bid * NTHR + get_tid(); i < n8; i += (long)nblk * NTHR) {
    const f4v a = *(const f4v*)(src + i * 8), b = *(const f4v*)(src + i * 8 + 4);
    h8v o = {(hf)a[0], (hf)a[1], (hf)a[2], (hf)a[3], (hf)b[0], (hf)b[1], (hf)b[2], (hf)b[3]};
    *(h8v*)(dst + i * 8) = o;
  }
}
PHASE void prologue_a(PP p, char* lds, int bid, int nblk) {
  const int tid = get_tid(), wid = tid >> 6, lane = tid & 63;
  {
    float* sin_ = (float*)lds;
    float* red = (float*)lds + 3072;
    for (int i = tid; i < 3072; i += NTHR) { const int v = i >> 10, k = i & 1023; const float x = v < 2 ? p->in[I_C][v * 1024 + k] : p->in[I_CCTX][k]; sin_[i] = silu(x); }
    __syncthreads();
    float* MOD = (float*)(p->ws + OFF_MOD);
    for (int it = bid; it < 4 * 96; it += nblk) {
      const int l = it / 96, cg = it - l * 96, col = cg * 64 + lane;
      const float* w = p->in[I_WMOD] + ((size_t)l * 1024 + wid * 128) * 6144 + col;
      float a0 = 0.f, a1 = 0.f, a2 = 0.f;
      for (int k0 = 0; k0 < 128; k0 += 32) {
        float wv[32];
#pragma unroll
        for (int k = 0; k < 32; ++k) wv[k] = __builtin_nontemporal_load(w + (size_t)(k0 + k) * 6144);
#pragma unroll
        for (int k = 0; k < 32; ++k) { const int kk = wid * 128 + k0 + k; a0 += sin_[kk] * wv[k]; a1 += sin_[1024 + kk] * wv[k]; a2 += sin_[2048 + kk] * wv[k]; }
      }
      red[(wid * 3 + 0) * 64 + lane] = a0; red[(wid * 3 + 1) * 64 + lane] = a1; red[(wid * 3 + 2) * 64 + lane] = a2;
      __syncthreads();
      if (tid < 192) { const int v = tid >> 6, c = tid & 63; float s = p->in[I_BMOD][(size_t)l * 6144 + cg * 64 + c];
#pragma unroll
        for (int w8 = 0; w8 < 8; ++w8) s += red[(w8 * 3 + v) * 64 + c];
        MOD[((size_t)(l * 3 + v)) * 6144 + cg * 64 + c] = s; }
      __syncthreads();
    }
  }
  for (int it = bid * 4; it < p->ntiles; it += nblk * 4) {
    int jn = 0;
    for (int q = 1; q < p->njobs; ++q) if (it >= p->jobs[q].tile0) jn = q;
    TJob jb; jb.src = p->jobs[jn].src; jb.dst = p->jobs[jn].dst; jb.gs = p->jobs[jn].gs; jb.K = p->jobs[jn].K; jb.N = p->jobs[jn].N; jb.Npad = p->jobs[jn].Npad; jb.tile0 = p->jobs[jn].tile0;
    const int jend = jn + 1 < p->njobs ? p->jobs[jn + 1].tile0 : p->ntiles;
    const int ntl = jend - it < 4 ? jend - it : 4;
    transpose_tiles(jb, it - jb.tile0, ntl, lds);
  }
  convert_f16(p->in[I_EK1], (hf*)(p->ws + OFF_K1), (long)4 * 8 * 128 * 128 / 8, bid, nblk);
  convert_f16(p->in[I_EK2], (hf*)(p->ws + OFF_K2), (long)4 * 8 * 128 * 128 / 8, bid, nblk);
  for (int tb = 0; tb < 2; ++tb) {
    const float* src = p->in[tb ? I_EV : I_EU]; unsigned char* dst = (unsigned char*)(p->ws + (tb ? OFF_V8 : OFF_U8)); float* scl = (float*)(p->ws + (tb ? OFF_SV : OFF_SU));
    for (int row0 = (bid * 8 + wid) * 4; row0 < 4 * NEXP; row0 += nblk * 8 * 4) {
      f4v a[4][4];
#pragma unroll
      for (int rr = 0; rr < 4; ++rr)
#pragma unroll
        for (int k = 0; k < 4; ++k) a[rr][k] = __builtin_nontemporal_load((const f4v*)(src + (size_t)(row0 + rr) * 1024 + lane * 4 + k * 256));
#pragma unroll
      for (int rr = 0; rr < 4; ++rr) {
        const int row = row0 + rr; float mx = 0.f;
#pragma unroll
        for (int k = 0; k < 4; ++k) mx = fmaxf(mx, fmaxf(fmaxf(fabsf(a[rr][k][0]), fabsf(a[rr][k][1])), fmaxf(fabsf(a[rr][k][2]), fabsf(a[rr][k][3]))));
#pragma unroll
        for (int o = 32; o > 0; o >>= 1) mx = fmaxf(mx, __shfl_xor(mx, o));
        const float sc = fmaxf(mx, 1e-30f) * (1.f / 448.f), inv = 1.f / sc;
        const int layer = row >> 14, e = row & (NEXP - 1);
#pragma unroll
        for (int k = 0; k < 4; ++k) {
          int w = __builtin_amdgcn_cvt_pk_fp8_f32(a[rr][k][0] * inv, a[rr][k][1] * inv, 0, false); w = __builtin_amdgcn_cvt_pk_fp8_f32(a[rr][k][2] * inv, a[rr][k][3] * inv, w, true);
          const int col = k * 256 + lane * 4;
          *(int*)(dst + ((size_t)(layer * 8 + (col >> 7)) * NEXP + e) * 128 + (col & 127)) = w;
        }
        if (lane == 0) scl[row] = sc;
      }
    }
  }
  {
    float* cosT = (float*)(p->ws + OFF_ROPE); float* sinT = cosT + 8192 * 32;
    for (int i = bid * NTHR + tid; i < 8192 * 32; i += nblk * NTHR) {
      const int s = i >> 5, j = i & 31; const float fr = powf(10000.f, -(float)(j & 15) / 16.f);
      const float pos = (float)(j < 16 ? (s >> 6) : (s & 63)); const float ang = pos * fr;
      cosT[i] = cosf(ang); sinT[i] = sinf(ang);
    }
  }
}
PHASE void prologue_b(PP p, int bid, int nblk) {
  hf* X = (hf*)(p->ws + OFF_X); hf* H = (hf*)(p->ws + OFF_H);
  const long total = (long)MALL * 128, stride = (long)nblk * NTHR;
  for (long idx0 = (long)bid * NTHR + get_tid(); idx0 < total; idx0 += 4 * stride) {
    f4v a[4], b[4];
#pragma unroll
    for (int k = 0; k < 4; ++k) { const long idx = idx0 + k * stride; const long ii = idx < total ? idx : idx0; const int row = (int)(ii >> 7), c0 = (int)(ii & 127) * 8;
      const float* src = row < NTOK ? p->in[I_X] + (size_t)row * 1024 : p->in[I_CTX] + (size_t)(row - NTOK) * 1024;
      a[k] = *(const f4v*)(src + c0); b[k] = *(const f4v*)(src + c0 + 4); }
#pragma unroll
    for (int k = 0; k < 4; ++k) { const long idx = idx0 + k * stride; if (idx >= total) break; const int row = (int)(idx >> 7), c0 = (int)(idx & 127) * 8;
      { h8v xv = {(hf)a[k][0], (hf)a[k][1], (hf)a[k][2], (hf)a[k][3], (hf)b[k][0], (hf)b[k][1], (hf)b[k][2], (hf)b[k][3]}; *(h8v*)(X + (size_t)row * 1024 + c0) = xv; }
      const float* sh = modp(p, 0, row, 0); const float* sc = modp(p, 0, row, 1);
      h8v o;
#pragma unroll
      for (int i = 0; i < 4; ++i) { o[i] = (hf)(a[k][i] * (1.f + sc[c0 + i]) + sh[c0 + i]); o[4 + i] = (hf)(b[k][i] * (1.f + sc[c0 + 4 + i]) + sh[c0 + 4 + i]); }
      *(h8v*)(H + (size_t)row * 1024 + c0) = o; }
  }
}

constexpr int NSUB = 11;
constexpr int NPHASE = 2 + NSUB * DEPTH;
DEV void run_phase(PP p, int ph, char* lds, int bid, int nblk, bool dry, bool one_launch) {
  if (ph == 0) { prologue_a(p, lds, bid, nblk); return; }
  if (ph == 1) { prologue_b(p, bid, nblk); return; }
  const int layer = (ph - 2) / NSUB, sub = (ph - 2) - layer * NSUB, j = layer >> 1;
  const int M = layer < 2 ? MALL : NTOK;
  char* ws = p->ws;
  const float* cosT = (const float*)(ws + OFF_ROPE); const float* sinT = cosT + 8192 * 32;
  if (sub >= 4) {
    if (sub == 4) ln_phase(p, layer, 0, M, bid, nblk, dry);
    else if (sub == 5) { EpiStore e{(hf*)(ws + OFF_PQ), 2048, nullptr};
      gemm_phase<EpiStore>((const hf*)(ws + OFF_H), 1024, (const hf*)(ws + OFF_PEERWQ) + (size_t)layer * 2048 * 1024, 1024, M, 2048, 1024, 0, e, lds, bid, nblk, dry); }
    else if (sub == 6) topk_phase(p, layer, M, lds, bid, nblk);
    else if (sub == 7) peer_u_phase(p, layer, M, get_role(p, lds, bid, nblk, one_launch), bid, nblk);
    else if (sub == 8) peer_w_phase(p, layer, M, bid, nblk);
    else if (sub == 9) peer_v_phase(p, layer, M, get_role(p, lds, bid, nblk, one_launch), bid, nblk);
    else ln_phase(p, layer, 1, M, bid, nblk, dry);
    return;
  }
  if ((layer & 1) == 0) {
    if (sub == 0) { EpiZ e{(hf*)(ws + OFF_Z), (hf*)(ws + OFF_KR), cosT, sinT, (float*)(ws + OFF_RSSP)};
      gemm_phase<EpiZ>((const hf*)(ws + OFF_H), 1024, (const hf*)(ws + OFF_WIN) + (size_t)j * 768 * 1024, 1024, MALL, 768, 1024, 0, e, lds, bid, nblk, dry); }
    else if (sub == 1) {
      { EpiQ e{(hf*)(ws + OFF_Q), (hf*)(ws + OFF_QC), cosT, sinT, (const float*)(ws + OFF_RSSP)};
        gemm_phase<EpiQ>((const hf*)(ws + OFF_Z), 768, (const hf*)(ws + OFF_WUQ) + (size_t)j * 1536 * 384, 384, NTOK, 1536, 384, 0, e, lds, bid, nblk, dry, NTOK, M); }
      { EpiKV e{(hf*)(ws + OFF_K), (long)((OFF_V - OFF_K) / 2), (const float*)(ws + OFF_RSSP)};
        gemm_phase<EpiKV>((const hf*)(ws + OFF_Z) + 384, 768, (const hf*)(ws + OFF_WUKV) + (size_t)j * 2048 * 256, 256, NTOK, 2048, 256, 0, e, lds, bid, nblk, dry, NTOK, MALL); }
    }
    else if (sub == 2) attn_phase(p, layer == 0, lds, bid, nblk, dry);
    else { EpiStore e{(hf*)(ws + OFF_Y), 1024, nullptr};
      gemm_phase<EpiStore>((const hf*)(ws + OFF_ATT), 1024, (const hf*)(ws + OFF_WO) + (size_t)j * 1024 * 1024, 1024, NTOK, 1024, 1024, 0, e, lds, bid, nblk, dry, NTOK, M); }
  } else {
    if (sub == 0) { EpiStore e{(hf*)(ws + OFF_Z), 1024, nullptr};
      gemm_phase<EpiStore>((const hf*)(ws + OFF_H), 1024, (const hf*)(ws + OFF_PWIN) + (size_t)j * 1024 * 1024, 1024, NTOK, 1024, 1024, 0, e, lds, bid, nblk, dry, NTOK, M); }
    else if (sub == 1) pool_phase(p, M, bid, nblk);
    else if (sub == 2) { EpiStore e{(hf*)(ws + OFF_PQ), 1024, p->in[I_PSCALE] + (size_t)j * 1024};
      gemm_phase<EpiStore>((const hf*)(ws + OFF_ATT), 1024, (const hf*)(ws + OFF_PGRP) + (size_t)j * 1024 * 256, 256, NTOK, 1024, 256, 256, e, lds, bid, nblk, dry, NTOK, M); }
    else { EpiStore e{(hf*)(ws + OFF_Y), 1024, nullptr};
      gemm_phase<EpiStore>((const hf*)(ws + OFF_PQ), 1024, (const hf*)(ws + OFF_PWOUT) + (size_t)j * 1024 * 1024, 1024, NTOK, 1024, 1024, 0, e, lds, bid, nblk, dry, NTOK, M); }
  }
}


#define XB_TMO      128
#define XB_XCNT(j)  (256  + 64 * (j))
#define XB_XSUB(j)  (1280 + 64 * (j))
#define XB_XGEN(j)  (2304 + 64 * (j))
#define XB_TOP      3328
#define XB_TOPGEN   3392
#define XB_RANK(j)  (3456 + 32 * (j))
#define XCD_BAR_WORDS 4096
#define XB_SPIN_CAP (1u << 22)
#define LAS __attribute__((address_space(3)))
DEV unsigned xb_ld(unsigned* p)              { return __hip_atomic_load(p, __ATOMIC_RELAXED, __HIP_MEMORY_SCOPE_AGENT); }
DEV unsigned xb_add(unsigned* p, unsigned v) { return __hip_atomic_fetch_add(p, v, __ATOMIC_RELAXED, __HIP_MEMORY_SCOPE_AGENT); }
DEV unsigned xb_xcc_id() { return (unsigned)__builtin_amdgcn_s_getreg((3 << 11) | 20) & 0xFu; }
#define XB_SPIN(cond, bar) do { unsigned _sp = 0; while (cond) { __builtin_amdgcn_s_sleep(1); \
    if ((++_sp & 255u) == 0u) { if (xb_ld(&(bar)[XB_TMO])) break; if (_sp > XB_SPIN_CAP) { atomicAdd(&(bar)[XB_TMO], 1u); break; } } } } while (0)
struct XcdBarrier { unsigned* bar; unsigned x; volatile LAS unsigned* st; };
DEV XcdBarrier xcd_barrier_post(unsigned* bar, volatile LAS unsigned* st) {
  XcdBarrier b; b.bar = bar; b.x = xb_xcc_id(); b.st = st;
  if (__builtin_amdgcn_workitem_id_x() == 0) (void)xb_add(&bar[XB_XCNT(b.x)], 1u);
  return b;
}
DEV void xcd_barrier_complete(unsigned* bar, unsigned x, unsigned& nloc, unsigned& nx) {
  const unsigned G = gridDim.x * gridDim.y * gridDim.z;
  unsigned sum, cnt, mine, sp = 0u;
  for (;;) {
    sum = 0u; cnt = 0u; mine = 0u;
#pragma unroll
    for (unsigned j = 0; j < 16; ++j) { const unsigned c = xb_ld(&bar[XB_XCNT(j)]); sum += c; cnt += (c > 0u) ? 1u : 0u; mine = (j == x) ? c : mine; }
    if (sum == G) break;
    __builtin_amdgcn_s_sleep(1);
    if ((++sp & 255u) == 0u) { if (xb_ld(&bar[XB_TMO])) break; if (sp > XB_SPIN_CAP) { atomicAdd(&bar[XB_TMO], 1u); break; } }
  }
  nloc = mine > 0u ? mine : 1u; nx = cnt > 0u ? cnt : 1u;
}
DEV void xcd_barrier(const XcdBarrier& b) {
  asm volatile("s_waitcnt vmcnt(0)" ::: "memory");
  __syncthreads();
  if (__builtin_amdgcn_workitem_id_x() == 0) {
    unsigned* bar = b.bar;
    __builtin_amdgcn_s_waitcnt(0);
    unsigned nloc = b.st[0], nx = b.st[1];
    if (nloc == 0u) { xcd_barrier_complete(bar, b.x, nloc, nx); b.st[0] = nloc; b.st[1] = nx; }
    const unsigned old = xb_add(&bar[XB_XSUB(b.x)], 1u);
    const unsigned gen = old / nloc;
    if (old + 1u == (gen + 1u) * nloc) {
      __builtin_amdgcn_fence(__ATOMIC_RELEASE, "agent");
      asm volatile("s_waitcnt vmcnt(0)" ::: "memory");
      const unsigned og = xb_add(&bar[XB_TOP], 1u);
      const unsigned tg = og / nx;
      if (og + 1u == (tg + 1u) * nx) xb_add(&bar[XB_TOPGEN], 1u);
      else XB_SPIN(xb_ld(&bar[XB_TOPGEN]) == tg, bar);
      __builtin_amdgcn_fence(__ATOMIC_ACQUIRE, "agent");
      xb_add(&bar[XB_XGEN(b.x)], 1u);
      asm volatile("s_waitcnt vmcnt(0)" ::: "memory");
    } else {
      XB_SPIN(xb_ld(&bar[XB_XGEN(b.x)]) == gen, bar);
      __builtin_amdgcn_fence(__ATOMIC_ACQUIRE, "agent");
      asm volatile("s_waitcnt vmcnt(0)" ::: "memory");
    }
  }
  __syncthreads();
}

DEV PP get_params() { PP kp = (PP)__builtin_amdgcn_kernarg_segment_ptr(); asm volatile("" : "+s"(kp)); return kp; }
__global__ void __launch_bounds__(NTHR, 2) mk_kernel(Params p_in_kernarg, int ph_begin, int ph_end) {
  extern __shared__ __attribute__((aligned(16))) char lds[];
  volatile LAS unsigned* st = (volatile LAS unsigned*)(lds + LDS_TOTAL);
  if (__builtin_amdgcn_workitem_id_x() == 0) {
#pragma unroll
    for (int i = 0; i < CTL_WORDS; ++i) st[i] = 0u;
    if (ph_end - ph_begin > 1) { unsigned* bar = (unsigned*)(get_params()->ws + OFF_BAR); const unsigned x = xb_xcc_id(); st[3] = x; st[2] = xb_add(&bar[XB_RANK(x)], 1u); }
  }
  __syncthreads();
  if (ph_end - ph_begin > 1) (void)xcd_barrier_post((unsigned*)(get_params()->ws + OFF_BAR), st);
  for (int ph = ph_begin; ph < ph_end; ++ph) {
    const int reps = (ph == PROBE_PH) ? PROBE_N : 0;
    for (int rep = reps; rep >= 0; --rep) {
      int bid = blockIdx.x, nblk = gridDim.x; asm volatile("" : "+s"(bid), "+s"(nblk));
      run_phase(get_params(), ph, lds, bid, nblk, rep > 0, ph_end - ph_begin > 1);
      if (ph + 1 < ph_end || rep > 0) { if (ph == ph_begin && rep == 0) cg::this_grid().sync(); else { XcdBarrier xb; xb.bar = (unsigned*)(get_params()->ws + OFF_BAR); xb.x = xb_xcc_id(); xb.st = (volatile LAS unsigned*)(lds + LDS_TOTAL); xcd_barrier(xb); } }
    }
  }
}

static void add_job(Params& p, const float* src, hf* dst, const float* gs, int K, int N, int Npad) {
  TJob& j = p.jobs[p.njobs]; j.src = src; j.dst = dst; j.gs = gs; j.K = K; j.N = N; j.Npad = Npad; j.tile0 = p.ntiles;
  p.ntiles += (K / 64) * (Npad / 64); p.njobs++;
}
extern "C" void kernel_launch(void* const* d_in, const int* in_sizes, int n_in, void* d_out, int out_size, void* d_ws, size_t ws_size, hipStream_t stream) {
  static int grid_blocks = 0;
  if (!grid_blocks) {
    if (n_in != 23 || ws_size < WS_END) { fprintf(stderr, "kernel_launch: unexpected inputs (n_in %d, ws %zu < %zu)\n", n_in, ws_size, (size_t)WS_END); return; }
    if (hipFuncSetAttribute((const void*)mk_kernel, hipFuncAttributeMaxDynamicSharedMemorySize, LDS_TOTAL + 32) != hipSuccess) { fprintf(stderr, "kernel_launch: LDS attribute failed\n"); return; }
    int dev = 0, cus = 0, per_cu = 0;
    hipGetDevice(&dev); hipDeviceGetAttribute(&cus, hipDeviceAttributeMultiprocessorCount, dev);
    hipOccupancyMaxActiveBlocksPerMultiprocessor(&per_cu, mk_kernel, NTHR, LDS_TOTAL + 32);
    if (per_cu < 1) { fprintf(stderr, "kernel_launch: occupancy query returned %d\n", per_cu); return; }
    grid_blocks = cus;
  }
  Params p; memset(&p, 0, sizeof(p));
  for (int i = 0; i < 23; ++i) p.in[i] = (const float*)d_in[i];
  p.out = (float*)d_out; p.ws = (char*)d_ws;
  char* ws = (char*)d_ws;
  for (int j = 0; j < 2; ++j) {
    add_job(p, p.in[I_MWIN] + (size_t)j * 1024 * 704, (hf*)(ws + OFF_WIN) + (size_t)j * 768 * 1024, nullptr, 1024, 704, 768);
    add_job(p, p.in[I_MWUQ] + (size_t)j * 384 * 1536, (hf*)(ws + OFF_WUQ) + (size_t)j * 1536 * 384, p.in[I_MQN] + (size_t)j * 384, 384, 1536, 1536);
    add_job(p, p.in[I_MWUKV] + (size_t)j * 256 * 2048, (hf*)(ws + OFF_WUKV) + (size_t)j * 2048 * 256, p.in[I_MKVN] + (size_t)j * 256, 256, 2048, 2048);
    add_job(p, p.in[I_MWO] + (size_t)j * 1024 * 1024, (hf*)(ws + OFF_WO) + (size_t)j * 1024 * 1024, nullptr, 1024, 1024, 1024);
    add_job(p, p.in[I_PWIN] + (size_t)j * 1024 * 1024, (hf*)(ws + OFF_PWIN) + (size_t)j * 1024 * 1024, nullptr, 1024, 1024, 1024);
    add_job(p, p.in[I_PWOUT] + (size_t)j * 1024 * 1024, (hf*)(ws + OFF_PWOUT) + (size_t)j * 1024 * 1024, nullptr, 1024, 1024, 1024);
    for (int g = 0; g < 4; ++g)
      add_job(p, p.in[I_PGRP] + ((size_t)j * 4 + g) * 256 * 256, (hf*)(ws + OFF_PGRP) + ((size_t)j * 1024 + g * 256) * 256, nullptr, 256, 256, 256);
  }
  for (int l = 0; l < 4; ++l)
    add_job(p, p.in[I_EWQ] + (size_t)l * 1024 * 2048, (hf*)(ws + OFF_PEERWQ) + (size_t)l * 2048 * 1024, nullptr, 1024, 2048, 2048);
#if MK_ONE_LAUNCH
  hipMemsetAsync(ws + OFF_BAR, 0, 16384, stream);
  int b = 0, e = NPHASE; void* args[] = {&p, &b, &e};
  hipError_t err = hipLaunchCooperativeKernel((const void*)mk_kernel, dim3(grid_blocks), dim3(NTHR), args, LDS_TOTAL + 32, stream);
  if (err != hipSuccess) fprintf(stderr, "cooperative launch failed: %s\n", hipGetErrorString(err));
#else
  for (int ph = 0; ph < NPHASE; ++ph) hipLaunchKernelGGL(mk_kernel, dim3(grid_blocks), dim3(NTHR), LDS_TOTAL + 32, stream, p, ph, ph + 1);
#endif
}
```

```cpp
#include <hip/hip_runtime.h>
#include <hip/hip_cooperative_groups.h>
#include <cstdio>
#include <cstdint>
#include <cstring>
namespace cg = cooperative_groups;

#ifndef MK_ONE_LAUNCH
#define MK_ONE_LAUNCH 1
#endif

#ifndef PROBE_PH
#define PROBE_PH -1
#endif
#ifndef PROBE_N
#define PROBE_N 0
#endif
#ifndef PROBE_MODE
#define PROBE_MODE 0
#endif
#define DEV __device__ __forceinline__
#define PHASE __device__ __forceinline__
typedef _Float16 hf;
typedef _Float16 h2v __attribute__((ext_vector_type(2)));
typedef _Float16 h4v __attribute__((ext_vector_type(4)));
typedef _Float16 h8v __attribute__((ext_vector_type(8)));
typedef short s4v __attribute__((ext_vector_type(4)));
typedef float f4v __attribute__((ext_vector_type(4)));
typedef float f16v __attribute__((ext_vector_type(16)));
typedef unsigned u4v __attribute__((ext_vector_type(4)));
typedef int i4v __attribute__((ext_vector_type(4)));
typedef float f2v __attribute__((ext_vector_type(2)));

constexpr int DM = 1024, NB = 2, SEQ = 8192, DEPTH = 4, CTXL = 256;
constexpr int NTOK = NB * SEQ;
constexpr int NCTX = NB * CTXL;
constexpr int MALL = NTOK + NCTX;
constexpr int TKV = SEQ + CTXL;
constexpr int NH = 8, DK = 192, DV = 128;
constexpr int NEXP = 16384;
constexpr float ALPHA = 1.681792830507429f;
constexpr float LN_EPS = 1e-5f, RMS_EPS = 1e-6f;
constexpr int NTHR = 512;

constexpr size_t al256(size_t x) { return (x + 255) & ~(size_t)255; }
constexpr size_t OFF_BAR = 0;
constexpr size_t OFF_MOD = 16384;
constexpr size_t OFF_ROPE = OFF_MOD + al256((size_t)4 * 3 * 6144 * 4);
constexpr size_t OFF_X = OFF_ROPE + (size_t)2 * 8192 * 32 * 4;
constexpr size_t SZ_A32 = (size_t)MALL * 1024 * 4, SZ_A16 = (size_t)MALL * 1024 * 2;
constexpr size_t OFF_H = OFF_X + SZ_A32;
constexpr size_t OFF_Z = OFF_H + SZ_A16;
constexpr size_t OFF_ATT = OFF_Z + SZ_A16;
constexpr size_t OFF_Y = OFF_ATT + SZ_A16;
constexpr size_t OFF_PQ = OFF_Y + SZ_A16;
constexpr size_t OFF_Q = OFF_PQ + 2 * SZ_A16;
constexpr size_t OFF_QC = OFF_Q + (size_t)NB * NH * SEQ * DK * 2;
constexpr size_t OFF_K = OFF_QC + (size_t)NB * NH * CTXL * DK * 2;
constexpr size_t OFF_KR = OFF_K + (size_t)NB * NH * TKV * 128 * 2;
constexpr size_t OFF_V = OFF_KR + (size_t)NB * TKV * 64 * 2;
constexpr size_t OFF_IDX = OFF_V + (size_t)NB * NH * TKV * DV * 2;
constexpr size_t OFF_G = OFF_IDX + (size_t)MALL * 128 * 4;
constexpr size_t OFF_WIN = OFF_G + (size_t)MALL * 128 * 4;
constexpr size_t OFF_WUQ = OFF_WIN + (size_t)2 * 768 * 1024 * 2;
constexpr size_t OFF_WUKV = OFF_WUQ + (size_t)2 * 1536 * 384 * 2;
constexpr size_t OFF_WO = OFF_WUKV + (size_t)2 * 2048 * 256 * 2;
constexpr size_t OFF_PWIN = OFF_WO + (size_t)2 * 1024 * 1024 * 2;
constexpr size_t OFF_PGRP = OFF_PWIN + (size_t)2 * 1024 * 1024 * 2;
constexpr size_t OFF_PWOUT = OFF_PGRP + (size_t)2 * 1024 * 256 * 2;
constexpr size_t OFF_PEERWQ = OFF_PWOUT + (size_t)2 * 1024 * 1024 * 2;
constexpr size_t OFF_K1 = OFF_PEERWQ + (size_t)4 * 2048 * 1024 * 2;
constexpr size_t OFF_K2 = OFF_K1 + (size_t)4 * 8 * 128 * 128 * 2;
constexpr size_t OFF_U8 = OFF_K2 + (size_t)4 * 8 * 128 * 128 * 2;
constexpr size_t OFF_V8 = OFF_U8 + (size_t)4 * NEXP * 1024;
constexpr size_t OFF_SU = OFF_V8 + (size_t)4 * NEXP * 1024;
constexpr size_t OFF_SV = OFF_SU + (size_t)4 * NEXP * 4;
constexpr size_t OFF_PD = OFF_SV + (size_t)4 * NEXP * 4;
constexpr size_t OFF_W = OFF_PD + (size_t)8 * MALL * 128 * 4;
constexpr size_t OFF_RSSP = OFF_W + (size_t)MALL * 128 * 4;
constexpr size_t OFF_H8 = OFF_RSSP + (size_t)MALL * 8 * 4;
constexpr size_t OFF_HS = OFF_H8 + (size_t)MALL * 1024;
constexpr size_t OFF_WSC = OFF_HS + (size_t)MALL * 4;
constexpr size_t OFF_W8 = OFF_W + (size_t)MALL * 128 * 2;
constexpr size_t OFF_SUV = OFF_WSC + (size_t)MALL * 4;
constexpr size_t OFF_SUVH = OFF_SUV + (size_t)4 * NEXP * 8;
constexpr size_t OFF_SUT = OFF_SUVH + (size_t)4 * NEXP * 4;
constexpr size_t WS_END = OFF_SUT + (size_t)MALL * 128 * 4;

struct TJob { const float* src; hf* dst; const float* gs; int K, N, Npad, tile0; };
constexpr int NJOBS = 28;
struct Params {
  const float* in[23];
  float* out;
  char* ws;
  TJob jobs[NJOBS];
  int njobs, ntiles, pad0, pad1;
};
typedef const __attribute__((address_space(4))) Params* PP;
enum { I_X = 0, I_C, I_CTX, I_CCTX, I_WMOD, I_BMOD, I_LNG, I_LNB, I_MWIN, I_MQN, I_MKVN, I_MWUQ, I_MWUKV, I_MWO, I_PWIN, I_PGRP, I_PSCALE, I_PWOUT, I_EWQ, I_EK1, I_EK2, I_EU, I_EV };

DEV int get_tid() { int t = __builtin_amdgcn_workitem_id_x(); asm volatile("" : "+v"(t)); return t; }
DEV int crow(int r, int hi) { return (r & 3) + 8 * (r >> 2) + 4 * hi; }
template <int CTRL> DEV float dpp_mov(float v) { return __builtin_bit_cast(float, __builtin_amdgcn_update_dpp(0, __builtin_bit_cast(int, v), CTRL, 0xF, 0xF, true)); }
DEV float wave_sum(float v) {
  v += dpp_mov<0xB1>(v); v += dpp_mov<0x4E>(v); v += dpp_mov<0x141>(v); v += dpp_mov<0x140>(v);
  { auto r = __builtin_amdgcn_permlane16_swap(__float_as_uint(v), __float_as_uint(v), false, false); v = __uint_as_float(r[0]) + __uint_as_float(r[1]); }
  { auto r = __builtin_amdgcn_permlane32_swap(__float_as_uint(v), __float_as_uint(v), false, false); v = __uint_as_float(r[0]) + __uint_as_float(r[1]); }
  return v;
}
DEV float wave_max(float v) {
  v = fmaxf(v, dpp_mov<0xB1>(v)); v = fmaxf(v, dpp_mov<0x4E>(v)); v = fmaxf(v, dpp_mov<0x141>(v)); v = fmaxf(v, dpp_mov<0x140>(v));
  { auto r = __builtin_amdgcn_permlane16_swap(__float_as_uint(v), __float_as_uint(v), false, false); v = fmaxf(__uint_as_float(r[0]), __uint_as_float(r[1])); }
  { auto r = __builtin_amdgcn_permlane32_swap(__float_as_uint(v), __float_as_uint(v), false, false); v = fmaxf(__uint_as_float(r[0]), __uint_as_float(r[1])); }
  return v;
}
DEV float dot8(h8v a, h8v b, float c) {
  const h2v* pa = (const h2v*)&a; const h2v* pb = (const h2v*)&b;
#pragma unroll
  for (int i = 0; i < 4; ++i) c = __builtin_amdgcn_fdot2(pa[i], pb[i], c, false);
  return c;
}
DEV float silu(float x) { return x / (1.f + __expf(-x)); }

constexpr int G_BM = 256, G_BN = 128, G_BK = 64;
constexpr int LDS_A_BYTES = G_BM * G_BK * 2, LDS_B_BYTES = G_BN * G_BK * 2;
constexpr int G_STAGES = 3;
constexpr int LDS_RS_OFF = G_STAGES * (LDS_A_BYTES + LDS_B_BYTES);
constexpr int NQL = 0;
constexpr int LDS_ATT = 5 * 16384 + 3 * 24576 + 2048 + 8 * NQL * 1024, LDS_GEMM = LDS_RS_OFF + 2048;
constexpr int LDS_TOTAL = LDS_ATT > LDS_GEMM ? LDS_ATT : LDS_GEMM;
DEV int swz(int row, int ch) { return row * 128 + ((ch ^ ((row >> 1) & 7)) << 4); }
DEV void glds16(const hf* src, char* lds_dst) { __builtin_amdgcn_global_load_lds((const unsigned*)src, (unsigned __attribute__((address_space(3)))*)lds_dst, 16, 0, 0); }


DEV h4v pack4(float a, float b, float c, float d) { h4v t; t[0] = (hf)a; t[1] = (hf)b; t[2] = (hf)c; t[3] = (hf)d; return t; }
DEV int row_mi(int row) { return row < NTOK ? row >> 13 : 2; }
DEV h8v resid8(h8v y, const hf* xp, const float* gp) {
  const h8v x = *(const h8v*)xp; const f4v g0 = *(const f4v*)gp, g1 = *(const f4v*)(gp + 4); h8v o;
#pragma unroll
  for (int i = 0; i < 8; ++i) o[i] = (hf)(ALPHA * (float)x[i] + (i < 4 ? g0[i & 3] : g1[i & 3]) * (float)y[i]);
  return o;
}
DEV void stage_rows(char* stage, const float (&f)[2][16], int r32, int hi, hf* dst0, int stride, const hf* xres0 = nullptr, const float* gate = nullptr) {
  const int lane = r32 + 32 * hi;
#pragma unroll
  for (int ni = 0; ni < 2; ++ni)
#pragma unroll
    for (int g = 0; g < 4; ++g) *(h4v*)(stage + r32 * 144 + (ni * 32 + g * 8 + 4 * hi) * 2) = pack4(f[ni][4 * g], f[ni][4 * g + 1], f[ni][4 * g + 2], f[ni][4 * g + 3]);
  asm volatile("s_waitcnt lgkmcnt(0)" ::: "memory");
  hf* dst = dst0 + (size_t)(lane >> 3) * stride + (lane & 7) * 8;
#pragma unroll
  for (int i = 0; i < 4; ++i) { h8v v = *(const h8v*)(stage + (i * 8 + (lane >> 3)) * 144 + (lane & 7) * 16);
    if (xres0) v = resid8(v, xres0 + (size_t)(lane >> 3) * stride + (lane & 7) * 8 + (size_t)(i * 8) * stride, gate + (lane & 7) * 8);
    *(h8v*)(dst + (size_t)(i * 8) * stride) = v; }
  asm volatile("s_waitcnt lgkmcnt(0)" ::: "memory");
}
struct EpiStore {
  static constexpr bool MINI_OK = true; static constexpr int CTX_MODE = 0;
  hf* out; int ldo; const float* cscale; const hf* resX; const float* gate0;
  template <int MI> DEV void operator()(const f16v (&acc)[2][MI], int m0, int n0, int wr, int wc, int r32, int hi, float*, char* stage) const {
    const int cb = n0 + wc * 64 + 4 * hi;
    f4v cs[2][4];
#pragma unroll
    for (int ni = 0; ni < 2; ++ni)
#pragma unroll
      for (int g = 0; g < 4; ++g) { cs[ni][g] = (f4v){1.f, 1.f, 1.f, 1.f}; if (cscale) cs[ni][g] = *(const f4v*)(cscale + cb + ni * 32 + g * 8); }
#pragma unroll
    for (int mi = 0; mi < MI; ++mi) {
      float f[2][16];
#pragma unroll
      for (int ni = 0; ni < 2; ++ni)
#pragma unroll
        for (int r = 0; r < 16; ++r) f[ni][r] = acc[ni][mi][r] * cs[ni][r >> 2][r & 3];
      const size_t o_ = (size_t)(m0 + wr * 64 + mi * 32) * ldo + n0 + wc * 64;
      stage_rows(stage, f, r32, hi, out + o_, ldo, resX ? resX + o_ : (const hf*)nullptr, resX ? gate0 + row_mi(m0) * 6144 + n0 + wc * 64 : (const float*)nullptr);
    }
  }
};
DEV bool tile_is_x(int m0) { return m0 < NTOK; }
DEV int tile_batch(int m0) { return m0 < NTOK ? (m0 >> 13) : ((m0 - NTOK) >> 8); }
DEV int tile_t0(int m0) { return m0 < NTOK ? (m0 & 8191) : SEQ + ((m0 - NTOK) & 255); }
struct EpiZ {
  static constexpr bool MINI_OK = false; static constexpr int CTX_MODE = -1;
  hf* Z; hf* KR; const float* cosT; const float* sinT; float* RSSP;
  template <int MI> DEV void operator()(const f16v (&acc)[2][MI], int m0, int n0, int wr, int wc, int r32, int hi, float* rsl, char* stage) const {
    static_assert(MI == 2, "EpiZ reduces its row statistics across the workgroup: full tiles only");
#pragma unroll
    for (int mi = 0; mi < 2; ++mi) { float q = 0.f;
#pragma unroll
      for (int ni = 0; ni < 2; ++ni)
#pragma unroll
        for (int r = 0; r < 16; ++r) q = fmaf(acc[ni][mi][r], acc[ni][mi][r], q);
      { auto rr = __builtin_amdgcn_permlane32_swap(__float_as_uint(q), __float_as_uint(q), false, false); q = __uint_as_float(rr[0]) + __uint_as_float(rr[1]); }
      if (hi == 0) rsl[wc * 256 + wr * 64 + mi * 32 + r32] = q; }
    __syncthreads();
    { const int t = get_tid(); if (t < 256) RSSP[(size_t)(m0 + t) * 8 + (n0 >> 7)] = rsl[t] + rsl[256 + t]; }
    const bool isx = tile_is_x(m0);
#pragma unroll
    for (int mi = 0; mi < 2; ++mi) {
      const int lr = wr * 64 + mi * 32;
      float f[2][16];
#pragma unroll
      for (int ni = 0; ni < 2; ++ni)
#pragma unroll
        for (int r = 0; r < 16; ++r) f[ni][r] = acc[ni][mi][r];
      stage_rows(stage, f, r32, hi, Z + (size_t)(m0 + lr) * 768 + n0 + wc * 64, 768);
      if (n0 + wc * 64 == 640) {
        if (isx) { const int s = (m0 + lr + r32) & 8191;
#pragma unroll
          for (int g = 0; g < 4; ++g) { const f4v c = *(const f4v*)(cosT + s * 32 + g * 8 + 4 * hi), sn = *(const f4v*)(sinT + s * 32 + g * 8 + 4 * hi);
#pragma unroll
            for (int i = 0; i < 4; ++i) { const float x1 = acc[0][mi][4 * g + i], x2 = acc[1][mi][4 * g + i]; f[0][4 * g + i] = x1 * c[i] - x2 * sn[i]; f[1][4 * g + i] = x1 * sn[i] + x2 * c[i]; } } }
        stage_rows(stage, f, r32, hi, KR + ((size_t)tile_batch(m0) * TKV + tile_t0(m0) + lr) * 64, 64);
      }
    }
  }
};
constexpr float Q_PRESCALE = 0.07216878364870322f * 1.4426950408889634f;
struct EpiQ {
  static constexpr bool MINI_OK = true; static constexpr int CTX_MODE = 1;
  hf* Q; hf* Qc; const float* cosT; const float* sinT; const float* RSSP;
  template <int MI> DEV void operator()(const f16v (&acc)[2][MI], int m0, int n0, int wr, int wc, int r32, int hi, float*, char* stage) const {
    const int cc = (n0 + wc * 64) >> 6, head = cc / 3, part = cc - head * 3;
    const bool isx = tile_is_x(m0); const int b = tile_batch(m0);
    hf* base = isx ? Q + ((size_t)(b * NH + head) * SEQ + (m0 & 8191)) * DK : Qc + ((size_t)(b * NH + head) * CTXL + ((m0 - NTOK) & 255)) * DK;
#pragma unroll
    for (int mi = 0; mi < MI; ++mi) {
      const int lr = wr * 64 + mi * 32, row = m0 + lr + r32; const float* pp = RSSP + (size_t)row * 8; const float sc = rsqrtf((pp[0] + pp[1] + pp[2]) * (1.f / 384.f) + RMS_EPS) * Q_PRESCALE;
      float f[2][16];
      if (part == 2 && isx) { const int s = row & 8191;
#pragma unroll
        for (int g = 0; g < 4; ++g) { const f4v c = *(const f4v*)(cosT + s * 32 + g * 8 + 4 * hi), sn = *(const f4v*)(sinT + s * 32 + g * 8 + 4 * hi);
#pragma unroll
          for (int i = 0; i < 4; ++i) { const float x1 = acc[0][mi][4 * g + i] * sc, x2 = acc[1][mi][4 * g + i] * sc; f[0][4 * g + i] = x1 * c[i] - x2 * sn[i]; f[1][4 * g + i] = x1 * sn[i] + x2 * c[i]; } }
      } else {
#pragma unroll
        for (int ni = 0; ni < 2; ++ni)
#pragma unroll
          for (int r = 0; r < 16; ++r) f[ni][r] = acc[ni][mi][r] * sc;
      }
      stage_rows(stage, f, r32, hi, base + (size_t)lr * DK + part * 64, DK);
    }
  }
};
struct EpiKV {
  static constexpr bool MINI_OK = true; static constexpr int CTX_MODE = 2;
  hf* Kb; long voff; const float* RSSP;
  template <int MI> DEV void operator()(const f16v (&acc)[2][MI], int m0, int n0, int wr, int wc, int r32, int hi, float*, char* stage) const {
    const int cc = (n0 + wc * 64) >> 6, head = cc >> 2, part = cc & 3;
    hf* base = Kb + (part >= 2 ? voff : 0l) + ((size_t)(tile_batch(m0) * NH + head) * TKV + tile_t0(m0)) * 128 + (part & 1) * 64;
#pragma unroll
    for (int mi = 0; mi < MI; ++mi) {
      const int lr = wr * 64 + mi * 32, row = m0 + lr + r32; const float* pp = RSSP + (size_t)row * 8; const float sc = rsqrtf((pp[3] + pp[4]) * (1.f / 256.f) + RMS_EPS);
      float f[2][16];
#pragma unroll
      for (int ni = 0; ni < 2; ++ni)
#pragma unroll
        for (int r = 0; r < 16; ++r) f[ni][r] = acc[ni][mi][r] * sc;
      stage_rows(stage, f, r32, hi, base + (size_t)lr * 128, 128);
    }
  }
};

template <class Epi>
DEV void gemm_mini(const hf* A, int lda, const hf* Bt, int ldb, int N, int K, int group_k, const Epi& epi, char* lds, int bid, int nblk, int mini0, int mini1) {
  if constexpr (Epi::MINI_OK) {
  if (mini1 <= mini0) return;
  const int tid = get_tid(), wid = tid >> 6, lane = tid & 63, r32 = lane & 31, hi = lane >> 5;
  char* stage = lds + 2 * LDS_A_BYTES + 8192;
  float* part = (float*)lds;
  const int ncb = N >> 6, items = ((mini1 - mini0) >> 5) * ncb, kw = K >> 3;
  for (int it = bid; it < items; it += nblk) {
    const int rb = it / ncb, cbk = it - rb * ncb, r0 = mini0 + rb * 32, c0 = cbk * 64;
    const hf* Ap = A + (group_k ? (c0 / group_k) * group_k : 0) + (size_t)(r0 + r32) * lda + hi * 8 + wid * kw;
    const hf* B0 = Bt + (size_t)(c0 + r32) * ldb + hi * 8 + wid * kw; const hf* B1 = B0 + (size_t)32 * ldb;
    f16v acc[2][1];
#pragma unroll
    for (int r = 0; r < 16; ++r) { acc[0][0][r] = 0.f; acc[1][0][r] = 0.f; }
#define MINI_K(NS) do { h8v a_[NS], b0_[NS], b1_[NS];                                                                                             \
      _Pragma("unroll") for (int ks = 0; ks < NS; ++ks) { a_[ks] = *(const h8v*)(Ap + ks * 16); b0_[ks] = *(const h8v*)(B0 + ks * 16); b1_[ks] = *(const h8v*)(B1 + ks * 16); } \
      _Pragma("unroll") for (int ks = 0; ks < NS; ++ks) { acc[0][0] = __builtin_amdgcn_mfma_f32_32x32x16_f16(b0_[ks], a_[ks], acc[0][0], 0, 0, 0);                           \
                                                          acc[1][0] = __builtin_amdgcn_mfma_f32_32x32x16_f16(b1_[ks], a_[ks], acc[1][0], 0, 0, 0); } } while (0)
    if (kw == 128) MINI_K(8); else if (kw == 48) MINI_K(3); else MINI_K(2);
#undef MINI_K
#pragma unroll
    for (int ni = 0; ni < 2; ++ni)
#pragma unroll
      for (int r = 0; r < 16; ++r) part[(wid * 32 + ni * 16 + r) * 64 + lane] = acc[ni][0][r];
    __syncthreads();
    { float* red = part + 8 * 32 * 64;
#pragma unroll
      for (int v = 0; v < 4; ++v) { const int idx = wid * 4 + v; float sacc = 0.f;
#pragma unroll
        for (int w = 0; w < 8; ++w) sacc += part[(w * 32 + idx) * 64 + lane];
        red[idx * 64 + lane] = sacc; }
      __syncthreads();
      if (wid == 0) {
#pragma unroll
        for (int ni = 0; ni < 2; ++ni)
#pragma unroll
          for (int r = 0; r < 16; ++r) acc[ni][0][r] = red[(ni * 16 + r) * 64 + lane];
        epi.template operator()<1>(acc, r0, c0, 0, 0, r32, hi, (float*)(lds + LDS_RS_OFF), stage);
      }
    }
    __syncthreads();
  }
  }
}
typedef float f4acc __attribute__((ext_vector_type(4)));
template <int MODE>
PHASE void gemm_ctx16(const hf* A, int lda, const hf* Bt, int ldb, int N, int K, int group_k, hf* out, int ldo, const float* cscale, const hf* resX, const float* gate0,
                      const float* RSSP, long voff, char* lds, int bid, int nblk, int m_lo, int m_hi) {
  if (m_hi <= m_lo) return;
  const int ntn = N / 32, items = ((m_hi - m_lo) >> 7) * ntn;
  const int tid = get_tid(), wid = __builtin_amdgcn_readfirstlane(tid >> 6), lane = tid & 63, t16 = lane & 15, g = lane >> 4;
  const int wr = wid >> 1, wc = wid & 1;
  constexpr int CA = 128 * 128, CB = 32 * 128, CS = CA + CB, RING = 7;
  char* adst = lds + (wid * 16) * 128; char* bdst = lds + CA + ((wid & 3) * 8) * 128;
  const int nk = K / 64;
  for (int it = bid; it < items; it += nblk) {
    const int mt = it / ntn, nt = it - mt * ntn, m0 = m_lo + mt * 128, n0 = nt * 32;
    const hf* ag[2]; const hf* bgp;
    { const hf* Ap_ = A + (group_k ? (n0 / group_k) * group_k : 0);
#pragma unroll
      for (int j = 0; j < 2; ++j) { const int r = wid * 16 + j * 8 + (lane >> 3), c = (lane & 7) ^ ((r >> 1) & 7); ag[j] = Ap_ + (size_t)(m0 + r) * lda + c * 8; }
      const int rB = (wid & 3) * 8 + (lane >> 3), cB = (lane & 7) ^ ((rB >> 1) & 7); bgp = Bt + (size_t)(n0 + rB) * ldb + cB * 8; }
#define GC_ISSUE(slot, kt_) do { const int ko_ = ((kt_) < nk ? (kt_) : nk - 1) * 64; char* sb_ = (char*)0 + (slot) * CS;                                    \
      glds16(ag[0] + ko_, adst + (size_t)sb_); glds16(ag[1] + ko_, adst + (size_t)sb_ + 1024); glds16(bgp + ko_, bdst + (size_t)sb_); } while (0)
#pragma unroll
    for (int i = 0; i < RING - 1; ++i) GC_ISSUE(i, i);
    f4acc acc[2];
    acc[0] = (f4acc){0.f, 0.f, 0.f, 0.f}; acc[1] = (f4acc){0.f, 0.f, 0.f, 0.f};
    int cur = 0;
    for (int kt = 0; kt < nk; ++kt) {
      asm volatile("s_waitcnt vmcnt(15) lgkmcnt(0)" ::: "memory");
      __builtin_amdgcn_s_barrier();
      asm volatile("" ::: "memory");
      { const int nb = cur == 0 ? RING - 1 : cur - 1; GC_ISSUE(nb, kt + RING - 1); }
      const char* Ab = lds + cur * CS; const char* Bb = Ab + CA;
#pragma unroll
      for (int S = 0; S < 2; ++S) {
        const int ch_ = S * 4 + g;
        const h8v fb = *(const h8v*)(Bb + swz(wc * 16 + t16, ch_));
        const h8v fa0 = *(const h8v*)(Ab + swz(wr * 32 + t16, ch_)), fa1 = *(const h8v*)(Ab + swz(wr * 32 + 16 + t16, ch_));
        acc[0] = __builtin_amdgcn_mfma_f32_16x16x32_f16(fb, fa0, acc[0], 0, 0, 0);
        acc[1] = __builtin_amdgcn_mfma_f32_16x16x32_f16(fb, fa1, acc[1], 0, 0, 0);
      }
      cur = cur == RING - 1 ? 0 : cur + 1;
    }
#undef GC_ISSUE
    asm volatile("s_waitcnt vmcnt(0)" ::: "memory");
    if constexpr (MODE == 0) {
      const int col = n0 + wc * 16 + 4 * g;
      f4v cs = {1.f, 1.f, 1.f, 1.f}; if (cscale) cs = *(const f4v*)(cscale + col);
      f4v gt = {0.f, 0.f, 0.f, 0.f}; if (resX) gt = *(const f4v*)(gate0 + row_mi(m0) * 6144 + col);
#pragma unroll
      for (int t = 0; t < 2; ++t) { const size_t o_ = (size_t)(m0 + wr * 32 + t * 16 + t16) * ldo + col;
        float v0 = acc[t][0] * cs[0], v1 = acc[t][1] * cs[1], v2 = acc[t][2] * cs[2], v3 = acc[t][3] * cs[3];
        if (resX) { const h4v x_ = *(const h4v*)(resX + o_); v0 = ALPHA * (float)x_[0] + gt[0] * (float)(hf)v0; v1 = ALPHA * (float)x_[1] + gt[1] * (float)(hf)v1; v2 = ALPHA * (float)x_[2] + gt[2] * (float)(hf)v2; v3 = ALPHA * (float)x_[3] + gt[3] * (float)(hf)v3; }
        *(h4v*)(out + o_) = pack4(v0, v1, v2, v3); }
    } else {
      const int cc = n0 >> 6, cin = (n0 & 63) + wc * 16 + 4 * g, b = tile_batch(m0);
#pragma unroll
      for (int t = 0; t < 2; ++t) { const int lr = wr * 32 + t * 16 + t16, row = m0 + lr; const float* pp = RSSP + (size_t)row * 8;
        if constexpr (MODE == 1) { const int head = cc / 3, part = cc - head * 3;
          const float sc = rsqrtf((pp[0] + pp[1] + pp[2]) * (1.f / 384.f) + RMS_EPS) * Q_PRESCALE;
          hf* d_ = out + ((size_t)(b * NH + head) * CTXL + ((m0 - NTOK) & 255) + lr) * DK + part * 64 + cin;
          *(h4v*)d_ = pack4(acc[t][0] * sc, acc[t][1] * sc, acc[t][2] * sc, acc[t][3] * sc);
        } else { const int head = cc >> 2, part = cc & 3;
          const float sc = rsqrtf((pp[3] + pp[4]) * (1.f / 256.f) + RMS_EPS);
          hf* d_ = out + (part >= 2 ? voff : 0l) + ((size_t)(b * NH + head) * TKV + tile_t0(m0) + lr) * 128 + (part & 1) * 64 + cin;
          *(h4v*)d_ = pack4(acc[t][0] * sc, acc[t][1] * sc, acc[t][2] * sc, acc[t][3] * sc); } }
    }
    __syncthreads();
  }
}

template <class Epi> DEV void ctx_rows(const hf* A, int lda, const hf* Bt, int ldb, int N, int K, int group_k, const Epi& epi, char* lds, int bid, int nblk, int mini0, int mini1) {
  if constexpr (Epi::CTX_MODE == 1) gemm_ctx16<1>(A, lda, Bt, ldb, N, K, group_k, epi.Qc, 0, nullptr, nullptr, nullptr, epi.RSSP, 0l, lds, bid, nblk, mini0, mini1);
  else if constexpr (Epi::CTX_MODE == 2) gemm_ctx16<2>(A, lda, Bt, ldb, N, K, group_k, epi.Kb, 0, nullptr, nullptr, nullptr, epi.RSSP, epi.voff, lds, bid, nblk, mini0, mini1);
  else gemm_mini<Epi>(A, lda, Bt, ldb, N, K, group_k, epi, lds, bid, nblk, mini0, mini1);
}
template <class Epi>
PHASE void gemm_phase(const hf* A, int lda, const hf* Bt, int ldb, int M, int N, int K, int group_k, const Epi& epi, char* lds, int bid, int nblk, bool dry, int mini0 = 0, int mini1 = 0) {
  const int ntn = N / G_BN, ntm = M / G_BM, x = bid & 7, nx8 = nblk >> 3;
  const int myM = (ntm - x + 7) >> 3, nitems = myM * ntn;
  const int tid = get_tid(), wid = tid >> 6, lane = tid & 63, r32 = lane & 31, hi = lane >> 5;
  const int wr = wid >> 1, wc = wid & 1;
  char* As = lds; char* Bs = lds + G_STAGES * LDS_A_BYTES;
  char* adst = As + (wid * 32) * 128; char* bdst = Bs + (wid * 16) * 128;
  char* stage = wid < 7 ? As + 2 * LDS_A_BYTES + wid * 4608 : Bs + 2 * LDS_B_BYTES;
  const int nk = K / G_BK;
  const hf* ag[4]; const hf* bg[2];
#define G_PTRS(m0_, n0_) do { const hf* Ap_ = A + (group_k ? ((n0_) / group_k) * group_k : 0);                                                             \
    _Pragma("unroll") for (int j = 0; j < 4; ++j) { const int r = wid * 32 + j * 8 + (lane >> 3), c = (lane & 7) ^ ((r >> 1) & 7); ag[j] = Ap_ + (size_t)((m0_) + r) * lda + c * 8; } \
    _Pragma("unroll") for (int j = 0; j < 2; ++j) { const int r = wid * 16 + j * 8 + (lane >> 3), c = (lane & 7) ^ ((r >> 1) & 7); bg[j] = Bt + (size_t)((n0_) + r) * ldb + c * 8; } } while (0)
#define G_ISSUE(buf, ko) do { if (dry && PROBE_MODE == 2) break; _Pragma("unroll") for (int j = 0; j < 4; ++j) glds16(ag[j] + (ko), adst + (buf) * LDS_A_BYTES + j * 1024); \
    _Pragma("unroll") for (int j = 0; j < 2; ++j) glds16(bg[j] + (ko), bdst + (buf) * LDS_B_BYTES + j * 1024); } while (0)
  int li = bid >> 3;
  if (bid >= nx8 * 8 || li >= nitems) { ctx_rows<Epi>(A, lda, Bt, ldb, N, K, group_k, epi, lds, bid, nblk, mini0, mini1); return; }
  int m0, n0;
  { const int q = li / ntn, nt = li - q * ntn; m0 = (x + 8 * q) * G_BM; n0 = nt * G_BN; }
  G_PTRS(m0, n0); G_ISSUE(0, 0); if (nk > 1) G_ISSUE(1, G_BK);
  for (;;) {
    f16v acc[2][2];
#pragma unroll
    for (int i = 0; i < 2; ++i)
#pragma unroll
      for (int j = 0; j < 2; ++j)
#pragma unroll
        for (int r = 0; r < 16; ++r) acc[i][j][r] = 0.f;
    int cur = 0;
    for (int kt = 0; kt < nk; ++kt) {
      if (kt + 1 < nk) asm volatile("s_waitcnt vmcnt(6) lgkmcnt(0)" ::: "memory"); else asm volatile("s_waitcnt vmcnt(0) lgkmcnt(0)" ::: "memory");
      __builtin_amdgcn_s_barrier();
      asm volatile("" ::: "memory");
      const bool pf = (kt + 2 < nk) && !(dry && PROBE_MODE == 2); const int nb = cur == 0 ? 2 : cur - 1; const int pko = (kt + 2) * G_BK;
      const char* Ab = As + cur * LDS_A_BYTES; const char* Bb = Bs + cur * LDS_B_BYTES;
      if (!(dry && PROBE_MODE == 3)) {
        h8v fa[2][2], fb[2][2];
#define G_FRAG(S, ks_) do { const int ch_ = (ks_) * 2 + hi; fa[S][0] = *(const h8v*)(Ab + swz(wr * 64 + r32, ch_)); fa[S][1] = *(const h8v*)(Ab + swz(wr * 64 + 32 + r32, ch_)); \
          fb[S][0] = *(const h8v*)(Bb + swz(wc * 64 + r32, ch_)); fb[S][1] = *(const h8v*)(Bb + swz(wc * 64 + 32 + r32, ch_)); } while (0)
        G_FRAG(0, 0);
#pragma unroll
        for (int ks = 0; ks < 4; ++ks) {
          const int S = ks & 1;
          if (ks < 3) G_FRAG(S ^ 1, ks + 1);
          if (pf && ks < 3) {
            if (ks < 2) { glds16(ag[2 * ks] + pko, adst + nb * LDS_A_BYTES + (2 * ks) * 1024); glds16(ag[2 * ks + 1] + pko, adst + nb * LDS_A_BYTES + (2 * ks + 1) * 1024); }
            else { glds16(bg[0] + pko, bdst + nb * LDS_B_BYTES); glds16(bg[1] + pko, bdst + nb * LDS_B_BYTES + 1024); }
          }
          acc[0][0] = __builtin_amdgcn_mfma_f32_32x32x16_f16(fb[S][0], fa[S][0], acc[0][0], 0, 0, 0);
          acc[0][1] = __builtin_amdgcn_mfma_f32_32x32x16_f16(fb[S][0], fa[S][1], acc[0][1], 0, 0, 0);
          acc[1][0] = __builtin_amdgcn_mfma_f32_32x32x16_f16(fb[S][1], fa[S][0], acc[1][0], 0, 0, 0);
          acc[1][1] = __builtin_amdgcn_mfma_f32_32x32x16_f16(fb[S][1], fa[S][1], acc[1][1], 0, 0, 0);
          __builtin_amdgcn_sched_barrier(0);
        }
#undef G_FRAG
      }
      cur = cur == 2 ? 0 : cur + 1;
    }
    asm volatile("s_waitcnt lgkmcnt(0)" ::: "memory");
    __syncthreads();
    const int cm0 = m0, cn0 = n0;
    li += nx8;
    const bool more = li < nitems;
    if (more) { const int q = li / ntn, nt = li - q * ntn; m0 = (x + 8 * q) * G_BM; n0 = nt * G_BN; G_PTRS(m0, n0); G_ISSUE(0, 0); if (nk > 1) G_ISSUE(1, G_BK); }
    if (dry && PROBE_MODE == 1) { float sink = 0.f;
#pragma unroll
      for (int i = 0; i < 2; ++i)
#pragma unroll
        for (int j = 0; j < 2; ++j)
#pragma unroll
          for (int r = 0; r < 16; ++r) sink += acc[i][j][r];
      if (sink == 1.2345e-30f) *(float*)(lds + LDS_RS_OFF) = sink; }
    else epi(acc, cm0, cn0, wr, wc, r32, hi, (float*)(lds + LDS_RS_OFF), stage);
    if (!more) break;
  }
#undef G_PTRS
#undef G_ISSUE
  __syncthreads();
  ctx_rows<Epi>(A, lda, Bt, ldb, N, K, group_k, epi, lds, bid, nblk, mini0, mini1);
}

PHASE void gemm_phase16(const hf* A, int lda, const hf* Bt, int ldb, int M, int N, int K, int group_k, hf* out, int ldo, const float* cscale, char* lds, int bid, int nblk, bool dry, int mini0 = 0, int mini1 = 0, const hf* resX = nullptr, const float* gate0 = nullptr) {
  const EpiStore epi{out, ldo, cscale, resX, gate0};
  const int ntn = N / G_BN, ntm = M / G_BM, x = bid & 7, nx8 = nblk >> 3;
  const int myM = (ntm - x + 7) >> 3, nitems = myM * ntn;
  const int tid = get_tid(), wid = tid >> 6, lane = tid & 63, t16 = lane & 15, g = lane >> 4;
  const int wr = wid >> 1, wc = wid & 1;
  char* As = lds; char* Bs = lds + G_STAGES * LDS_A_BYTES;
  char* adst = As + (wid * 32) * 128; char* bdst = Bs + (wid * 16) * 128;
  char* stage = wid < 7 ? As + 2 * LDS_A_BYTES + wid * 4608 : Bs + 2 * LDS_B_BYTES;
  const int nk = K / G_BK;
  const hf* ag[4]; const hf* bg[2];
#define G_PTRS(m0_, n0_) do { const hf* Ap_ = A + (group_k ? ((n0_) / group_k) * group_k : 0);                                                             \
    _Pragma("unroll") for (int j = 0; j < 4; ++j) { const int r = wid * 32 + j * 8 + (lane >> 3), c = (lane & 7) ^ ((r >> 1) & 7); ag[j] = Ap_ + (size_t)((m0_) + r) * lda + c * 8; } \
    _Pragma("unroll") for (int j = 0; j < 2; ++j) { const int r = wid * 16 + j * 8 + (lane >> 3), c = (lane & 7) ^ ((r >> 1) & 7); bg[j] = Bt + (size_t)((n0_) + r) * ldb + c * 8; } } while (0)
#define G_ISSUE(buf, ko) do { _Pragma("unroll") for (int j = 0; j < 4; ++j) glds16(ag[j] + (ko), adst + (buf) * LDS_A_BYTES + j * 1024); \
    _Pragma("unroll") for (int j = 0; j < 2; ++j) glds16(bg[j] + (ko), bdst + (buf) * LDS_B_BYTES + j * 1024); } while (0)
  int li = bid >> 3;
  if (bid >= nx8 * 8 || li >= nitems) { gemm_ctx16<0>(A, lda, Bt, ldb, N, K, group_k, out, ldo, cscale, resX, gate0, nullptr, 0l, lds, bid, nblk, mini0, mini1); return; }
  int m0, n0;
  { const int q = li / ntn, nt = li - q * ntn; m0 = (x + 8 * q) * G_BM; n0 = nt * G_BN; }
  G_PTRS(m0, n0); G_ISSUE(0, 0); if (nk > 1) G_ISSUE(1, G_BK);
  for (;;) {
    f4acc acc[4][4];
#pragma unroll
    for (int i = 0; i < 4; ++i)
#pragma unroll
      for (int j = 0; j < 4; ++j) acc[i][j] = (f4acc){0.f, 0.f, 0.f, 0.f};
    int cur = 0;
    for (int kt = 0; kt < nk; ++kt) {
      if (kt + 1 < nk) asm volatile("s_waitcnt vmcnt(6) lgkmcnt(0)" ::: "memory"); else asm volatile("s_waitcnt vmcnt(0) lgkmcnt(0)" ::: "memory");
      __builtin_amdgcn_s_barrier();
      asm volatile("" ::: "memory");
      const bool pf = (kt + 2 < nk); const int nb = cur == 0 ? 2 : cur - 1; const int pko = (kt + 2) * G_BK;
      const char* Ab = As + cur * LDS_A_BYTES; const char* Bb = Bs + cur * LDS_B_BYTES;
      h8v fa[2][4], fb[2][4];
#define G_FRAG16(S) do { const int ch_ = (S) * 4 + g;                                                                                           \
        _Pragma("unroll") for (int t = 0; t < 4; ++t) { fa[S][t] = *(const h8v*)(Ab + swz(wr * 64 + t * 16 + t16, ch_)); fb[S][t] = *(const h8v*)(Bb + swz(wc * 64 + t * 16 + t16, ch_)); } } while (0)
      G_FRAG16(0);
      G_FRAG16(1);
#pragma unroll
      for (int S = 0; S < 2; ++S) {
#pragma unroll
        for (int hb = 0; hb < 2; ++hb) {
          const int grp = S * 2 + hb;
          if (pf && grp < 3) {
            if (grp < 2) { glds16(ag[2 * grp] + pko, adst + nb * LDS_A_BYTES + (2 * grp) * 1024); glds16(ag[2 * grp + 1] + pko, adst + nb * LDS_A_BYTES + (2 * grp + 1) * 1024); }
            else { glds16(bg[0] + pko, bdst + nb * LDS_B_BYTES); glds16(bg[1] + pko, bdst + nb * LDS_B_BYTES + 1024); }
          }
#pragma unroll
          for (int ct = 2 * hb; ct < 2 * hb + 2; ++ct)
#pragma unroll
            for (int tt = 0; tt < 4; ++tt) acc[ct][tt] = __builtin_amdgcn_mfma_f32_16x16x32_f16(fb[S][ct], fa[S][tt], acc[ct][tt], 0, 0, 0);
          __builtin_amdgcn_sched_barrier(0);
        }
      }
#undef G_FRAG16
      cur = cur == 2 ? 0 : cur + 1;
    }
    asm volatile("s_waitcnt lgkmcnt(0)" ::: "memory");
    __syncthreads();
    const int cm0 = m0, cn0 = n0;
    li += nx8;
    const bool more = li < nitems;
    if (more) { const int q = li / ntn, nt = li - q * ntn; m0 = (x + 8 * q) * G_BM; n0 = nt * G_BN; G_PTRS(m0, n0); G_ISSUE(0, 0); if (nk > 1) G_ISSUE(1, G_BK); }
    {
      f4v cs[4];
#pragma unroll
      for (int ct = 0; ct < 4; ++ct) { cs[ct] = (f4v){1.f, 1.f, 1.f, 1.f}; if (cscale) cs[ct] = *(const f4v*)(cscale + cn0 + wc * 64 + ct * 16 + 4 * g); }
#pragma unroll
      for (int hf2 = 0; hf2 < 2; ++hf2) {
#pragma unroll
        for (int t2 = 0; t2 < 2; ++t2)
#pragma unroll
          for (int ct = 0; ct < 4; ++ct) { const f4acc a = acc[ct][hf2 * 2 + t2];
            *(h4v*)(stage + (t2 * 16 + t16) * 144 + (ct * 16 + 4 * g) * 2) = pack4(a[0] * cs[ct][0], a[1] * cs[ct][1], a[2] * cs[ct][2], a[3] * cs[ct][3]); }
        asm volatile("s_waitcnt lgkmcnt(0)" ::: "memory");
        hf* dst = out + (size_t)(cm0 + wr * 64 + hf2 * 32 + (lane >> 3)) * ldo + cn0 + wc * 64 + (lane & 7) * 8;
#pragma unroll
        for (int i = 0; i < 4; ++i) { h8v v = *(const h8v*)(stage + (i * 8 + (lane >> 3)) * 144 + (lane & 7) * 16);
          if (resX) v = resid8(v, resX + (dst - out) + (size_t)(i * 8) * ldo, gate0 + row_mi(cm0) * 6144 + cn0 + wc * 64 + (lane & 7) * 8);
          *(h8v*)(dst + (size_t)(i * 8) * ldo) = v; }
        asm volatile("s_waitcnt lgkmcnt(0)" ::: "memory");
      }
    }
    if (!more) break;
  }
#undef G_PTRS
#undef G_ISSUE
  __syncthreads();
  gemm_ctx16<0>(A, lda, Bt, ldb, N, K, group_k, out, ldo, cscale, resX, gate0, nullptr, 0l, lds, bid, nblk, mini0, mini1);
}

constexpr int SHM_V = 64 * DV * 2, SHM_K = 64 * DK * 2;
#define KSWZ(row, colB) ((row) * 384 + ((colB) ^ ((((row) >> 1) & 7) << 4)))
#define SBAR() __builtin_amdgcn_sched_barrier(0)
constexpr float ATT_SCALE = 0.07216878364870322f;
constexpr float ATT_THR = 8.f;

DEV unsigned cvtpk(float lo, float hi) { h2v t; t.x = (hf)lo; t.y = (hf)hi; return *(unsigned*)&t; }

DEV void partialSM(f16v& p0, f16v& p1, float& m_reg, float& mn, float& alpha, bool dry = false) {
  if (dry && PROBE_MODE == 5) { mn = m_reg; alpha = 1.f; return; }
  constexpr float C = ATT_SCALE * 1.4426950408889634f;
  float pmax = p0[0];
#pragma unroll
  for (int r = 1; r < 16; ++r) pmax = fmaxf(pmax, p0[r]);
#pragma unroll
  for (int r = 0; r < 16; ++r) pmax = fmaxf(pmax, p1[r]);
  { auto rr = __builtin_amdgcn_permlane32_swap(__float_as_uint(pmax), __float_as_uint(pmax), false, false);
    pmax = fmaxf(__uint_as_float(rr[0]), __uint_as_float(rr[1])); }
  if (__builtin_expect(__all(pmax - m_reg <= ATT_THR / ATT_SCALE), 1)) { mn = m_reg; alpha = 1.f; }
  else { mn = fmaxf(m_reg, pmax); alpha = __builtin_amdgcn_exp2f((m_reg - mn) * C); m_reg = mn; }
  const float mnC = -mn * C;
#pragma unroll
  for (int r = 0; r < 16; ++r) p0[r] = fmaf(p0[r], C, mnC);
#pragma unroll
  for (int r = 0; r < 16; ++r) p1[r] = fmaf(p1[r], C, mnC);
#pragma unroll
  for (int r = 0; r < 16; ++r) p0[r] = __builtin_amdgcn_exp2f(p0[r]);
}
DEV void finishSM(f16v& p0, f16v& p1, float alpha, float& l_reg, h8v& pa0, h8v& pa1, h8v& pa2, h8v& pa3, bool dry = false) {
  if (dry && PROBE_MODE == 5) { l_reg += p0[0] + p1[0];
#pragma unroll
    for (int i = 0; i < 8; ++i) { pa0[i] = (hf)p0[i]; pa1[i] = (hf)p0[8 + i]; pa2[i] = (hf)p1[i]; pa3[i] = (hf)p1[8 + i]; } return; }
#pragma unroll
  for (int r = 0; r < 16; ++r) p1[r] = __builtin_amdgcn_exp2f(p1[r]);
  float ps = 0.f;
#pragma unroll
  for (int r = 0; r < 16; ++r) ps += p0[r];
#pragma unroll
  for (int r = 0; r < 16; ++r) ps += p1[r];
  { auto rr = __builtin_amdgcn_permlane32_swap(__float_as_uint(ps), __float_as_uint(ps), false, false);
    ps = __uint_as_float(rr[0]) + __uint_as_float(rr[1]); }
  l_reg = l_reg * alpha + ps;
#define PK4(P, BASE, OUT) do { unsigned a0 = cvtpk(P[BASE + 0], P[BASE + 1]), a1 = cvtpk(P[BASE + 2], P[BASE + 3]);   \
    unsigned b0 = cvtpk(P[BASE + 4], P[BASE + 5]), b1 = cvtpk(P[BASE + 6], P[BASE + 7]);                              \
    auto r0 = __builtin_amdgcn_permlane32_swap(a0, b0, false, false); auto r1 = __builtin_amdgcn_permlane32_swap(a1, b1, false, false); \
    u4v w = {r0[0], r1[0], r0[1], r1[1]}; OUT = *reinterpret_cast<h8v*>(&w); } while (0)
  PK4(p0, 0, pa0); PK4(p0, 8, pa1); PK4(p1, 0, pa2); PK4(p1, 8, pa3);
#undef PK4
}
DEV void qkt(f16v& p0, f16v& p1, const char* Ks, const h8v* qr, const char* qrl, int r32, int hi) {
#pragma unroll
  for (int r = 0; r < 16; ++r) { p0[r] = 0.f; p1[r] = 0.f; }
#pragma unroll
  for (int d0 = 0; d0 < 12; ++d0) {
    const int cb = (d0 * 16 + hi * 8) * 2;
    const h8v b0 = *reinterpret_cast<const h8v*>(Ks + KSWZ(r32, cb));
    const h8v b1 = *reinterpret_cast<const h8v*>(Ks + KSWZ(32 + r32, cb));
    const h8v q = d0 < 12 - NQL ? qr[d0 < 12 - NQL ? d0 : 0] : *reinterpret_cast<const h8v*>(qrl + (d0 - (12 - NQL)) * 1024);
    p0 = __builtin_amdgcn_mfma_f32_32x32x16_f16(b0, q, p0, 0, 0, 0);
    p1 = __builtin_amdgcn_mfma_f32_32x32x16_f16(b1, q, p1, 0, 0, 0);
  }
}
DEV int v_st(int k, int c) { const int kk = (k & ~0xC) | ((k & 4) << 1) | ((k & 8) >> 1); return ((kk >> 3) * 4 + (c >> 5)) * 512 + ((kk & 7) * 32 + (c & 31)) * 2; }
DEV int v_rd_base(int lane) { return ((lane & 3) << 3) | (((lane >> 2) & 3) << 6) | (((lane >> 4) & 1) << 5) | (((lane >> 5) & 1) << 8); }
constexpr int v_rd_off(int d0, int ks, int half) { return d0 * 512 + ks * 4096 + half * 2048; }
template <int OFF> DEV s4v tr_read(int vb) {
  s4v r; asm volatile("ds_read_b64_tr_b16 %0, %1 offset:%2" : "=&v"(r) : "v"(vb), "i"(OFF) : "memory"); return r;
}
template <int D0> DEV void pv_one(f16v& od, int vb, h8v pa0, h8v pa1, h8v pa2, h8v pa3) {
  const s4v l0 = tr_read<v_rd_off(D0, 0, 0)>(vb), h0 = tr_read<v_rd_off(D0, 0, 1)>(vb), l1 = tr_read<v_rd_off(D0, 1, 0)>(vb), h1 = tr_read<v_rd_off(D0, 1, 1)>(vb);
  const s4v l2 = tr_read<v_rd_off(D0, 2, 0)>(vb), h2 = tr_read<v_rd_off(D0, 2, 1)>(vb), l3 = tr_read<v_rd_off(D0, 3, 0)>(vb), h3 = tr_read<v_rd_off(D0, 3, 1)>(vb);
  asm volatile("s_waitcnt lgkmcnt(0)" ::: "memory"); SBAR();
#define PKV(L, H) ({ s4v l_ = (L), h_ = (H); short __attribute__((ext_vector_type(8))) t_ = {l_[0], l_[1], l_[2], l_[3], h_[0], h_[1], h_[2], h_[3]}; *reinterpret_cast<h8v*>(&t_); })
  od = __builtin_amdgcn_mfma_f32_32x32x16_f16(pa0, PKV(l0, h0), od, 0, 0, 0);
  od = __builtin_amdgcn_mfma_f32_32x32x16_f16(pa1, PKV(l1, h1), od, 0, 0, 0);
  od = __builtin_amdgcn_mfma_f32_32x32x16_f16(pa2, PKV(l2, h2), od, 0, 0, 0);
  od = __builtin_amdgcn_mfma_f32_32x32x16_f16(pa3, PKV(l3, h3), od, 0, 0, 0);
#undef PKV
}
DEV void pv_d0(f16v* o, int vb, h8v pa0, h8v pa1, h8v pa2, h8v pa3) {
  pv_one<0>(o[0], vb, pa0, pa1, pa2, pa3); pv_one<1>(o[1], vb, pa0, pa1, pa2, pa3); pv_one<2>(o[2], vb, pa0, pa1, pa2, pa3); pv_one<3>(o[3], vb, pa0, pa1, pa2, pa3);
}

DEV void attn_body(const hf* __restrict__ Qb, const hf* __restrict__ Kh, const hf* __restrict__ Rh, const hf* __restrict__ Vh, hf* __restrict__ Ob, int seq, char* lds, bool dry) {
  const int tid = get_tid(), wid = tid >> 6, lane = tid & 63, r32 = lane & 31, hi = lane >> 5;
  char* V_lds = lds; char* K_lds = lds + 2 * SHM_V;
  float* wsm = (float*)(lds + 2 * SHM_V + 2 * SHM_K) + wid * 64; float* li_l = wsm; float* al_l = wsm + 32;
  float m_reg = -1e30f, l_reg = 0.f; f16v o[4]; h8v qr[12 - NQL];
  char* qrl = lds + 2 * SHM_V + 2 * SHM_K + 2048 + wid * (NQL * 1024) + lane * 16;
#pragma unroll
  for (int d = 0; d < 4; ++d)
#pragma unroll
    for (int r = 0; r < 16; ++r) o[d][r] = 0.f;
  const hf* Qw = Qb + (size_t)(wid * 32 + r32) * DK + hi * 8;
#pragma unroll
  for (int d0 = 0; d0 < 12 - NQL; ++d0) qr[d0] = *(const h8v*)(Qw + d0 * 16);
#pragma unroll
  for (int d0 = 12 - NQL; d0 < 12; ++d0) *(h8v*)(qrl + (d0 - (12 - NQL)) * 1024) = *(const h8v*)(Qw + d0 * 16);
  const int sr = tid >> 4, sc = (tid & 15) * 8, vst0 = v_st(sr, sc), vst1 = v_st(32 + sr, sc);
  const int krow = tid >> 3, kch = tid & 7, kst = KSWZ(krow, kch * 16);
  const int vb0 = (int)(uintptr_t)V_lds + v_rd_base(lane);
  const hf* Vg = Vh + (size_t)sr * DV + sc; const hf* Kg = Kh + (size_t)krow * 128 + kch * 8; const hf* Rg = Rh + (size_t)krow * 64 + kch * 8;
  h8v vs0 = {}, vs1 = {}, ks0 = {}, ks1 = {}, ks2 = {};
#define SLOAD(k0) do { if (dry && PROBE_MODE == 6) break; vs0 = *(const h8v*)(Vg + (size_t)(k0) * DV); vs1 = *(const h8v*)(Vg + (size_t)((k0) + 32) * DV); \
    ks0 = *(const h8v*)(Kg + (size_t)(k0) * 128); ks1 = *(const h8v*)(Kg + (size_t)(k0) * 128 + 64); ks2 = *(const h8v*)(Rg + (size_t)(k0) * 64); } while (0)
#define SWRITE(b) do { if (dry && PROBE_MODE == 6) break; *(h8v*)(V_lds + (b) * SHM_V + vst0) = vs0; *(h8v*)(V_lds + (b) * SHM_V + vst1) = vs1;          \
    *(h8v*)(K_lds + (b) * SHM_K + kst) = ks0; *(h8v*)(K_lds + (b) * SHM_K + kst + 128) = ks1; *(h8v*)(K_lds + (b) * SHM_K + kst + 256) = ks2; } while (0)
#define RESC(a) do { if (__any((a) < 1.f)) { if (hi == 0) al_l[r32] = (a); asm volatile("s_waitcnt lgkmcnt(0)" ::: "memory"); \
    _Pragma("unroll") for (int d = 0; d < 4; ++d) _Pragma("unroll") for (int r = 0; r < 16; ++r) o[d][r] *= al_l[crow(r, hi)]; } } while (0)
  f16v pA0, pA1, pB0, pB1; float mnA, mnB, alA, alB; h8v pa0, pa1, pa2, pa3; const int NT = seq / 64;
  SLOAD(0); SWRITE(0); __syncthreads();
  qkt(pA0, pA1, K_lds, qr, qrl, r32, hi); partialSM(pA0, pA1, m_reg, mnA, alA, dry);
  SLOAD(64);
  SWRITE(1); __syncthreads();
  for (int j = 1; j + 1 < NT; j += 2) {
    SBAR(); qkt(pB0, pB1, K_lds + SHM_K, qr, qrl, r32, hi);
    finishSM(pA0, pA1, alA, l_reg, pa0, pa1, pa2, pa3, dry); SBAR();
    SLOAD((j + 1) * 64); SBAR();
    if (!(dry && PROBE_MODE == 4)) pv_d0(o, vb0, pa0, pa1, pa2, pa3); partialSM(pB0, pB1, m_reg, mnB, alB, dry);
    __syncthreads(); SWRITE(0);
    RESC(alB); __syncthreads();
    SBAR(); qkt(pA0, pA1, K_lds, qr, qrl, r32, hi);
    finishSM(pB0, pB1, alB, l_reg, pa0, pa1, pa2, pa3, dry); SBAR();
    SLOAD((j + 2) * 64); SBAR();
    if (!(dry && PROBE_MODE == 4)) pv_d0(o, vb0 + SHM_V, pa0, pa1, pa2, pa3); partialSM(pA0, pA1, m_reg, mnA, alA, dry);
    __syncthreads(); SWRITE(1);
    RESC(alA); __syncthreads();
  }
  SBAR(); qkt(pB0, pB1, K_lds + SHM_K, qr, qrl, r32, hi);
  finishSM(pA0, pA1, alA, l_reg, pa0, pa1, pa2, pa3, dry); SBAR();
  if (!(dry && PROBE_MODE == 4)) pv_d0(o, vb0, pa0, pa1, pa2, pa3); partialSM(pB0, pB1, m_reg, mnB, alB, dry);
  __syncthreads(); RESC(alB);
  finishSM(pB0, pB1, alB, l_reg, pa0, pa1, pa2, pa3, dry); SBAR();
  if (!(dry && PROBE_MODE == 4)) pv_d0(o, vb0 + SHM_V, pa0, pa1, pa2, pa3);
  if (hi == 0) li_l[r32] = l_reg; asm volatile("s_waitcnt lgkmcnt(0)" ::: "memory");
  float rli[16];
#pragma unroll
  for (int r = 0; r < 16; ++r) rli[r] = __builtin_amdgcn_rcpf(li_l[crow(r, hi)]);
  hf* Ow = Ob + (size_t)(wid * 32) * 1024;
#pragma unroll
  for (int r = 0; r < 16; ++r) { const int orow = crow(r, hi);
#pragma unroll
    for (int d0 = 0; d0 < 4; ++d0) Ow[(size_t)orow * 1024 + d0 * 32 + r32] = (hf)(o[d0][r] * rli[r]); }
  __syncthreads();
#undef SLOAD
#undef SWRITE
#undef RESC
}


constexpr int AK_SLOT = 24576, AV_SLOT = 16384, A_RING = 3;
constexpr int A_VOFF = A_RING * AK_SLOT, A_WOFF = A_VOFF + A_RING * AV_SLOT, A_QOFF = A_WOFF + 2048;
template <int OFF> DEV h8v ldsr16(int a) { h8v r; asm volatile("ds_read_b128 %0, %1 offset:%2" : "=&v"(r) : "v"(a), "i"(OFF) : "memory"); return r; }
template <int D0> DEV void qk_issue(h8v& ka, h8v& kbv, const int (&kb)[4]) { ka = ldsr16<(D0 >> 2) * 8192>(kb[D0 & 3]); kbv = ldsr16<(D0 >> 2) * 8192 + 4096>(kb[D0 & 3]); }
template <int D0> DEV void qk_step(f16v& p0, f16v& p1, h8v (&k0)[3], h8v (&k1)[3], const int (&kb)[4], const h8v* qr) {
  if constexpr (D0 + 2 < 12) qk_issue<D0 + 2>(k0[(D0 + 2) % 3], k1[(D0 + 2) % 3], kb);
  constexpr int N = (D0 + 2 < 12) ? 4 : (D0 + 1 < 12 ? 2 : 0);
  asm volatile("s_waitcnt lgkmcnt(%0)" :: "i"(N) : "memory"); SBAR();
  p0 = __builtin_amdgcn_mfma_f32_32x32x16_f16(k0[D0 % 3], qr[D0], p0, 0, 0, 0);
  p1 = __builtin_amdgcn_mfma_f32_32x32x16_f16(k1[D0 % 3], qr[D0], p1, 0, 0, 0);
  SBAR();
}
DEV void qkt2(f16v& p0, f16v& p1, const int (&kb)[4], const h8v* qr, const char*) {
  static_assert(NQL == 0, "qkt2 keeps all twelve q fragments in registers");
#pragma unroll
  for (int r = 0; r < 16; ++r) { p0[r] = 0.f; p1[r] = 0.f; }
  h8v k0[3], k1[3];
  asm volatile("s_waitcnt lgkmcnt(0)" ::: "memory"); SBAR();
  qk_issue<0>(k0[0], k1[0], kb); qk_issue<1>(k0[1], k1[1], kb);
  __builtin_amdgcn_s_setprio(1);
  qk_step<0>(p0, p1, k0, k1, kb, qr); qk_step<1>(p0, p1, k0, k1, kb, qr); qk_step<2>(p0, p1, k0, k1, kb, qr); qk_step<3>(p0, p1, k0, k1, kb, qr);
  qk_step<4>(p0, p1, k0, k1, kb, qr); qk_step<5>(p0, p1, k0, k1, kb, qr); qk_step<6>(p0, p1, k0, k1, kb, qr); qk_step<7>(p0, p1, k0, k1, kb, qr);
  qk_step<8>(p0, p1, k0, k1, kb, qr); qk_step<9>(p0, p1, k0, k1, kb, qr); qk_step<10>(p0, p1, k0, k1, kb, qr); qk_step<11>(p0, p1, k0, k1, kb, qr);
  __builtin_amdgcn_s_setprio(0);
}
DEV unsigned pk2h(float a, float b) { return cvtpk(a, b); }
#define PK4S(P, BASE, OUT) do { unsigned a0 = cvtpk(P[BASE + 0], P[BASE + 1]), a1 = cvtpk(P[BASE + 2], P[BASE + 3]);   \
    unsigned b0 = cvtpk(P[BASE + 4], P[BASE + 5]), b1 = cvtpk(P[BASE + 6], P[BASE + 7]);                              \
    auto r0 = __builtin_amdgcn_permlane32_swap(a0, b0, false, false); auto r1 = __builtin_amdgcn_permlane32_swap(a1, b1, false, false); \
    u4v w = {r0[0], r1[0], r0[1], r1[1]}; OUT = *reinterpret_cast<h8v*>(&w); } while (0)
template <int S> DEV void fsm_slice(f16v& P0, f16v& P1, float& ps, float alpha, float& l_reg, h8v& pa0, h8v& pa1, h8v& pa2, h8v& pa3) {
  if constexpr (S < 8) { P1[2 * S] = __builtin_amdgcn_exp2f(P1[2 * S]); P1[2 * S + 1] = __builtin_amdgcn_exp2f(P1[2 * S + 1]); }
  if constexpr (S == 0) ps = (P0[0] + P0[1]) + (P0[2] + P0[3]);
  if constexpr (S >= 1 && S < 4) ps += (P0[4 * S] + P0[4 * S + 1]) + (P0[4 * S + 2] + P0[4 * S + 3]);
  if constexpr (S == 4 || S == 5) ps += (P1[4 * (S - 4)] + P1[4 * (S - 4) + 1]) + (P1[4 * (S - 4) + 2] + P1[4 * (S - 4) + 3]);
  if constexpr (S == 6) PK4S(P0, 0, pa0);
  if constexpr (S == 7) PK4S(P0, 8, pa1);
  if constexpr (S == 8) { ps += (P1[8] + P1[9]) + (P1[10] + P1[11]); PK4S(P1, 0, pa2); }
  if constexpr (S == 9) { ps += (P1[12] + P1[13]) + (P1[14] + P1[15]); PK4S(P1, 8, pa3); }
  if constexpr (S == 10) { auto rr = __builtin_amdgcn_permlane32_swap(__float_as_uint(ps), __float_as_uint(ps), false, false);
    l_reg = l_reg * alpha + (__uint_as_float(rr[0]) + __uint_as_float(rr[1])); }
}
template <int D0, class DmaF> DEV void qkf_step(f16v& p0, f16v& p1, h8v (&k0)[3], h8v (&k1)[3], const int (&kb)[4], const h8v* qr,
                                    f16v& P0, f16v& P1, float& ps, float alpha, float& l_reg, h8v& pa0, h8v& pa1, h8v& pa2, h8v& pa3, const DmaF& dma) {
  if constexpr (D0 + 2 < 12) qk_issue<D0 + 2>(k0[(D0 + 2) % 3], k1[(D0 + 2) % 3], kb);
  constexpr int N = (D0 + 2 < 12) ? 4 : (D0 + 1 < 12 ? 2 : 0);
  asm volatile("s_waitcnt lgkmcnt(%0)" :: "i"(N) : "memory"); SBAR();
  p0 = __builtin_amdgcn_mfma_f32_32x32x16_f16(k0[D0 % 3], qr[D0], p0, 0, 0, 0);
  SBAR();
  fsm_slice<D0>(P0, P1, ps, alpha, l_reg, pa0, pa1, pa2, pa3);
  SBAR();
  p1 = __builtin_amdgcn_mfma_f32_32x32x16_f16(k1[D0 % 3], qr[D0], p1, 0, 0, 0);
  SBAR();
  if constexpr (D0 >= 1 && D0 <= 5) { dma(D0 - 1); SBAR(); }
}
template <class DmaF> DEV void qk_fsm(f16v& p0, f16v& p1, const int (&kb)[4], const h8v* qr, f16v& P0, f16v& P1, float alpha, float& l_reg, h8v& pa0, h8v& pa1, h8v& pa2, h8v& pa3, const DmaF& dma) {
#pragma unroll
  for (int r = 0; r < 16; ++r) { p0[r] = 0.f; p1[r] = 0.f; }
  h8v k0[3], k1[3]; float ps = 0.f;
  asm volatile("s_waitcnt lgkmcnt(0)" ::: "memory"); SBAR();
  qk_issue<0>(k0[0], k1[0], kb); qk_issue<1>(k0[1], k1[1], kb);
#define QKF(D) qkf_step<D>(p0, p1, k0, k1, kb, qr, P0, P1, ps, alpha, l_reg, pa0, pa1, pa2, pa3, dma)
  QKF(0); QKF(1); QKF(2); QKF(3); QKF(4); QKF(5); QKF(6); QKF(7); QKF(8); QKF(9); QKF(10); QKF(11);
#undef QKF
}
DEV void attn_body_dma(const hf* __restrict__ Qb, const hf* __restrict__ Kh, const hf* __restrict__ Rh, const hf* __restrict__ Vh, hf* __restrict__ Ob, int seq, char* lds, bool dry) {
  const int tid = get_tid(), wid = tid >> 6, lane = tid & 63, r32 = lane & 31, hi = lane >> 5;
  float* wsm = (float*)(lds + A_WOFF) + wid * 64; float* li_l = wsm; float* al_l = wsm + 32;
  float m_reg = -1e30f, l_reg = 0.f; f16v o[4]; h8v qr[12 - NQL];
  char* qrl = lds + A_QOFF + wid * (NQL * 1024) + lane * 16;
#pragma unroll
  for (int d = 0; d < 4; ++d)
#pragma unroll
    for (int r = 0; r < 16; ++r) o[d][r] = 0.f;
  const hf* Qw = Qb + (size_t)(wid * 32 + r32) * DK + hi * 8;
#pragma unroll
  for (int d0 = 0; d0 < 12 - NQL; ++d0) qr[d0] = *(const h8v*)(Qw + d0 * 16);
#pragma unroll
  for (int d0 = 12 - NQL; d0 < 12; ++d0) *(h8v*)(qrl + (d0 - (12 - NQL)) * 1024) = *(const h8v*)(Qw + d0 * 16);
  const hf *sk0, *sk1, *sk2, *sv0, *sv1;
  { const int row = 8 * wid + (lane >> 3), c = (lane & 7) ^ ((row >> 1) & 7);
    sk0 = Kh + (size_t)row * 128 + c * 8; sk1 = sk0 + 64; sk2 = Rh + (size_t)row * 64 + c * 8;
    const int st0 = 4 * wid + (lane >> 5), st1 = st0 + 2;
    const int kk0 = (st0 >> 2) * 8 + ((lane & 31) >> 2), kk1 = (st1 >> 2) * 8 + ((lane & 31) >> 2);
    const int k0_ = (kk0 & ~0xC) | ((kk0 & 4) << 1) | ((kk0 & 8) >> 1), k1_ = (kk1 & ~0xC) | ((kk1 & 4) << 1) | ((kk1 & 8) >> 1);
    sv0 = Vh + (size_t)k0_ * 128 + (st0 & 3) * 32 + (lane & 3) * 8; sv1 = Vh + (size_t)k1_ * 128 + (st1 & 3) * 32 + (lane & 3) * 8; }
  char* kdst = lds + wid * 1024; char* vdst = lds + A_VOFF + wid * 2048;
#define A_DMA(slot, t) do { if (dry && PROBE_MODE == 6) break; const size_t ko_ = (size_t)(t) * 64; char* kd_ = kdst + (slot) * AK_SLOT; char* vd_ = vdst + (slot) * AV_SLOT;         \
    glds16(sk0 + ko_ * 128, kd_); glds16(sk1 + ko_ * 128, kd_ + 8192); glds16(sk2 + ko_ * 64, kd_ + 16384); glds16(sv0 + ko_ * 128, vd_); glds16(sv1 + ko_ * 128, vd_ + 1024); } while (0)
  int ko4[4];
#pragma unroll
  for (int j = 0; j < 4; ++j) ko4[j] = (int)(uintptr_t)lds + r32 * 128 + (((2 * j + hi) ^ ((r32 >> 1) & 7)) << 4);
  const int vb0 = (int)(uintptr_t)lds + A_VOFF + v_rd_base(lane);
#define RESC2(a) do { if (__any((a) < 1.f)) { if (hi == 0) al_l[r32] = (a); asm volatile("s_waitcnt lgkmcnt(0)" ::: "memory"); \
    _Pragma("unroll") for (int d = 0; d < 4; ++d) _Pragma("unroll") for (int r = 0; r < 16; ++r) o[d][r] *= al_l[crow(r, hi)]; } } while (0)
#define A_KB(slot) do { _Pragma("unroll") for (int j = 0; j < 4; ++j) kb[j] = ko4[j] + (slot) * AK_SLOT; } while (0)
#define A_NEXT(s_) ((s_) == 2 ? 0 : (s_) + 1)
  f16v pA0, pA1, pB0, pB1; float mnA, mnB, alA, alB; h8v pa0, pa1, pa2, pa3; const int NT = seq / 64;
  int kb[4];
  int dt = -1, dsl = 0;
  auto dma_piece = [&](int i) { if (dt < 0 || (dry && PROBE_MODE == 6)) return; const size_t ko_ = (size_t)dt * 64; char* kd_ = kdst + dsl * AK_SLOT; char* vd_ = vdst + dsl * AV_SLOT;
    if (i == 0) glds16(sk0 + ko_ * 128, kd_); else if (i == 1) glds16(sk1 + ko_ * 128, kd_ + 8192); else if (i == 2) glds16(sk2 + ko_ * 64, kd_ + 16384);
    else if (i == 3) glds16(sv0 + ko_ * 128, vd_); else glds16(sv1 + ko_ * 128, vd_ + 1024); };
  A_DMA(0, 0); A_DMA(1, 1);
  __syncthreads();
  A_KB(0); qkt2(pA0, pA1, kb, qr, qrl); partialSM(pA0, pA1, m_reg, mnA, alA, dry);
  if (2 < NT) { dt = 2; dsl = 2; }
  int sc = 1;
  for (int j = 1; j + 1 < NT; j += 2) {
    { const int sp = sc == 0 ? 2 : sc - 1;
      SBAR(); A_KB(sc); qk_fsm(pB0, pB1, kb, qr, pA0, pA1, alA, l_reg, pa0, pa1, pa2, pa3, dma_piece); SBAR();
      if (!(dry && PROBE_MODE == 4)) pv_d0(o, vb0 + sp * AV_SLOT, pa0, pa1, pa2, pa3);
      partialSM(pB0, pB1, m_reg, mnB, alB, dry);
      __syncthreads();
      dt = (j + 2 < NT) ? j + 2 : -1; dsl = sp;
      RESC2(alB); sc = A_NEXT(sc); }
    { const int sp = sc == 0 ? 2 : sc - 1;
      SBAR(); A_KB(sc); qk_fsm(pA0, pA1, kb, qr, pB0, pB1, alB, l_reg, pa0, pa1, pa2, pa3, dma_piece); SBAR();
      if (!(dry && PROBE_MODE == 4)) pv_d0(o, vb0 + sp * AV_SLOT, pa0, pa1, pa2, pa3);
      partialSM(pA0, pA1, m_reg, mnA, alA, dry);
      __syncthreads();
      dt = (j + 3 < NT) ? j + 3 : -1; dsl = sp;
      RESC2(alA); sc = A_NEXT(sc); }
  }
  { const int sp = sc == 0 ? 2 : sc - 1;
    SBAR(); A_KB(sc); qk_fsm(pB0, pB1, kb, qr, pA0, pA1, alA, l_reg, pa0, pa1, pa2, pa3, dma_piece); SBAR();
    if (!(dry && PROBE_MODE == 4)) pv_d0(o, vb0 + sp * AV_SLOT, pa0, pa1, pa2, pa3);
    partialSM(pB0, pB1, m_reg, mnB, alB, dry);
    RESC2(alB);
    finishSM(pB0, pB1, alB, l_reg, pa0, pa1, pa2, pa3, dry); SBAR();
    if (!(dry && PROBE_MODE == 4)) pv_d0(o, vb0 + sc * AV_SLOT, pa0, pa1, pa2, pa3); }
  if (hi == 0) li_l[r32] = l_reg; asm volatile("s_waitcnt lgkmcnt(0)" ::: "memory");
  float rli[16];
#pragma unroll
  for (int r = 0; r < 16; ++r) rli[r] = __builtin_amdgcn_rcpf(li_l[crow(r, hi)]);
  hf* Ow = Ob + (size_t)(wid * 32) * 1024;
#pragma unroll
  for (int r = 0; r < 16; ++r) { const int orow = crow(r, hi);
#pragma unroll
    for (int d0 = 0; d0 < 4; ++d0) Ow[(size_t)orow * 1024 + d0 * 32 + r32] = (hf)(o[d0][r] * rli[r]); }
  __syncthreads();
#undef A_DMA
#undef RESC2
#undef A_KB
#undef A_NEXT
}

DEV int v16_rd_base(int lane) { const int g = lane >> 4; return (g >> 1) * 2048 + ((g & 1) * 4 + ((lane >> 2) & 3)) * 32 + (lane & 3) * 8; }
constexpr int v16_off(int dt, int s2, int half) { return (4 * s2 + 2 * half) * 2048 + dt * 256; }
DEV float max4(f4acc a) { return fmaxf(fmaxf(a[0], a[1]), fmaxf(a[2], a[3])); }
DEV float sum4(f4acc a) { return (a[0] + a[1]) + (a[2] + a[3]); }
DEV h8v pack8(f4acc a, f4acc b) { u4v w = {cvtpk(a[0], a[1]), cvtpk(a[2], a[3]), cvtpk(b[0], b[1]), cvtpk(b[2], b[3])}; return *reinterpret_cast<h8v*>(&w); }
#define XRED2(x0, x1, OP) do { auto r_ = __builtin_amdgcn_permlane32_swap(__float_as_uint(x0), __float_as_uint(x1), false, false);                    \
    float a_ = OP(__uint_as_float(r_[0]), __uint_as_float(r_[1]));                                                                                  \
    r_ = __builtin_amdgcn_permlane16_swap(__float_as_uint(a_), __float_as_uint(a_), false, false); a_ = OP(__uint_as_float(r_[0]), __uint_as_float(r_[1])); \
    r_ = __builtin_amdgcn_permlane32_swap(__float_as_uint(a_), __float_as_uint(a_), false, false); x0 = __uint_as_float(r_[0]); x1 = __uint_as_float(r_[1]); } while (0)
DEV float opmax(float a, float b) { float d; asm("v_max_f32 %0, %1, %2" : "=v"(d) : "v"(a), "v"(b)); return d; }
DEV float opadd(float a, float b) { return a + b; }
DEV float max3f(float a, float b, float c) { float d; asm("v_max3_f32 %0, %1, %2, %3" : "=v"(d) : "v"(a), "v"(b), "v"(c)); return d; }
DEV float max16(const f4acc& a, const f4acc& b, const f4acc& c, const f4acc& d) {
  float t = max3f(a[0], a[1], a[2]), u = max3f(c[0], c[1], c[2]);
  t = max3f(t, a[3], b[0]); u = max3f(u, c[3], d[0]); t = max3f(t, b[1], b[2]); u = max3f(u, d[1], d[2]);
  return max3f(t, u, opmax(b[3], d[3]));
}
DEV float dot8ones(h8v v, float c) { const h2v one = {(hf)1.f, (hf)1.f}; const h2v* q = reinterpret_cast<const h2v*>(&v);
  c = __builtin_amdgcn_fdot2(q[0], one, c, false); c = __builtin_amdgcn_fdot2(q[1], one, c, false); c = __builtin_amdgcn_fdot2(q[2], one, c, false); return __builtin_amdgcn_fdot2(q[3], one, c, false); }
template <bool FIRST> DEV void psm16(f4acc (&p)[8], f4acc& cin0, f4acc& cin1, float& l0, float& l1, f4acc (&o)[16], float* al_l, h8v (&pa)[4], float& ps0) {
  constexpr float T2 = ATT_THR * 1.4426950408889634f;
  float x0 = max16(p[0], p[1], p[2], p[3]), x1 = max16(p[4], p[5], p[6], p[7]);
  XRED2(x0, x1, opmax);
  if (FIRST || !__builtin_expect(__all((x0 <= T2) & (x1 <= T2)), 1)) {
    const float d0 = FIRST ? x0 : fmaxf(x0, 0.f), d1 = FIRST ? x1 : fmaxf(x1, 0.f);
#pragma unroll
    for (int k = 0; k < 4; ++k)
#pragma unroll
      for (int i = 0; i < 4; ++i) { p[k][i] -= d0; p[4 + k][i] -= d1; }
    const float c0 = cin0[0] - d0, c1 = cin1[0] - d1;
    cin0 = (f4acc){c0, c0, c0, c0}; cin1 = (f4acc){c1, c1, c1, c1};
    if (!FIRST) {
      const float a0 = __builtin_amdgcn_exp2f(-d0), a1 = __builtin_amdgcn_exp2f(-d1);
      l0 *= a0; l1 *= a1;
      int z_ = 0; asm volatile("" : "+v"(z_));
      const int ln_ = __builtin_amdgcn_mbcnt_hi(~0u, __builtin_amdgcn_mbcnt_lo(~0u, z_)), q_ = ln_ & 15, g_ = ln_ >> 4;
      if (g_ == 0) { al_l[q_] = a0; al_l[16 + q_] = a1; } asm volatile("s_waitcnt lgkmcnt(0)" ::: "memory");
      const f4v s0_ = *(const f4v*)(al_l + 4 * g_), s1_ = *(const f4v*)(al_l + 16 + 4 * g_);
#pragma unroll
      for (int d = 0; d < 8; ++d)
#pragma unroll
        for (int i = 0; i < 4; ++i) { o[d][i] *= s0_[i]; o[8 + d][i] *= s1_[i]; }
    }
  }
#pragma unroll
  for (int k = 0; k < 4; ++k)
#pragma unroll
    for (int i = 0; i < 4; ++i) p[k][i] = __builtin_amdgcn_exp2f(p[k][i]);
  pa[0] = pack8(p[0], p[1]); pa[1] = pack8(p[2], p[3]);
  ps0 = dot8ones(pa[1], dot8ones(pa[0], 0.f));
}
template <int S> DEV void fsm16_slice(f4acc (&P)[8], float ps0, float& ps1, float& l0, float& l1, h8v (&pa)[4]) {
  if constexpr (S < 8) { constexpr int k = 4 + (S >> 1), i = (S & 1) * 2; P[k][i] = __builtin_amdgcn_exp2f(P[k][i]); P[k][i + 1] = __builtin_amdgcn_exp2f(P[k][i + 1]); }
  if constexpr (S == 4) { pa[2] = pack8(P[4], P[5]); ps1 = dot8ones(pa[2], 0.f); }
  if constexpr (S == 8) { pa[3] = pack8(P[6], P[7]); ps1 = dot8ones(pa[3], ps1); }
  if constexpr (S == 9) { XRED2(ps0, ps1, opadd); l0 += ps0; l1 += ps1; }
}
template <int D0> DEV void qk16_issue(h8v& ka, h8v& kbv, const int (&kb)[2]) {
  ka = ldsr16<(D0 >> 2) * 8192 + (2 * (D0 & 1)) * 2048>(kb[(D0 >> 1) & 1]); kbv = ldsr16<(D0 >> 2) * 8192 + (2 * (D0 & 1) + 1) * 2048>(kb[(D0 >> 1) & 1]); }
template <int D0, bool FSM, class DmaF> DEV void qk16_step(f4acc (&p)[8], h8v (&k0)[3], h8v (&k1)[3], const int (&kb)[2], const h8v* qr, const f4acc& cin0, const f4acc& cin1,
                                    f4acc (&P)[8], float ps0, float& ps1, float& l0, float& l1, h8v (&pa)[4], const DmaF& dma) {
  if constexpr (D0 + 2 < 12) qk16_issue<D0 + 2>(k0[(D0 + 2) % 3], k1[(D0 + 2) % 3], kb);
  constexpr int N = (D0 + 2 < 12) ? 4 : (D0 + 1 < 12 ? 2 : 0);
  constexpr int s = D0 >> 1, ka_ = 2 * (D0 & 1), kb_ = ka_ + 1;
  asm volatile("s_waitcnt lgkmcnt(%0)" :: "i"(N) : "memory"); SBAR();
  p[ka_] = __builtin_amdgcn_mfma_f32_16x16x32_f16(k0[D0 % 3], qr[s], s == 0 ? cin0 : p[ka_], 0, 0, 0);
  p[4 + ka_] = __builtin_amdgcn_mfma_f32_16x16x32_f16(k0[D0 % 3], qr[6 + s], s == 0 ? cin1 : p[4 + ka_], 0, 0, 0);
  SBAR();
  if constexpr (FSM) { fsm16_slice<D0>(P, ps0, ps1, l0, l1, pa); SBAR(); }
  p[kb_] = __builtin_amdgcn_mfma_f32_16x16x32_f16(k1[D0 % 3], qr[s], s == 0 ? cin0 : p[kb_], 0, 0, 0);
  p[4 + kb_] = __builtin_amdgcn_mfma_f32_16x16x32_f16(k1[D0 % 3], qr[6 + s], s == 0 ? cin1 : p[4 + kb_], 0, 0, 0);
  SBAR();
}
template <bool FSM, class DmaF> DEV void qk16(f4acc (&p)[8], const int (&kb)[2], const h8v* qr, const f4acc& cin0, const f4acc& cin1, f4acc (&P)[8], float ps0, float& l0, float& l1, h8v (&pa)[4], const DmaF& dma) {
  h8v k0[3], k1[3]; float ps1 = 0.f;
  asm volatile("s_waitcnt lgkmcnt(0)" ::: "memory"); SBAR();
  qk16_issue<0>(k0[0], k1[0], kb); qk16_issue<1>(k0[1], k1[1], kb);
#define QKF(D) qk16_step<D, FSM>(p, k0, k1, kb, qr, cin0, cin1, P, ps0, ps1, l0, l1, pa, dma)
  QKF(0); QKF(1); QKF(2); QKF(3); QKF(4); QKF(5); QKF(6); QKF(7); QKF(8); QKF(9); QKF(10); QKF(11);
#undef QKF
}
template <int DT> DEV void pv16_issue(s4v (&t)[4], int vb) {
  t[0] = tr_read<v16_off(DT, 0, 0)>(vb); t[1] = tr_read<v16_off(DT, 0, 1)>(vb); t[2] = tr_read<v16_off(DT, 1, 0)>(vb); t[3] = tr_read<v16_off(DT, 1, 1)>(vb); }
template <int DT, bool DMA, class DmaF> DEV void pv16_step(f4acc (&o)[16], s4v (&ta)[4], s4v (&tb)[4], int vb, const h8v (&pa)[4], const DmaF& dma) {
  if constexpr (DT < 7) pv16_issue<DT + 1>(tb, vb);
  asm volatile("s_waitcnt lgkmcnt(%0)" :: "i"(DT < 7 ? 4 : 0) : "memory"); SBAR();
#define PKV(L, H) ({ s4v l_ = (L), h_ = (H); short __attribute__((ext_vector_type(8))) t_ = {l_[0], l_[1], l_[2], l_[3], h_[0], h_[1], h_[2], h_[3]}; *reinterpret_cast<h8v*>(&t_); })
  const h8v V0 = PKV(ta[0], ta[1]), V1 = PKV(ta[2], ta[3]);
#undef PKV
  o[DT] = __builtin_amdgcn_mfma_f32_16x16x32_f16(pa[0], V0, o[DT], 0, 0, 0);
  o[8 + DT] = __builtin_amdgcn_mfma_f32_16x16x32_f16(pa[2], V0, o[8 + DT], 0, 0, 0);
  o[DT] = __builtin_amdgcn_mfma_f32_16x16x32_f16(pa[1], V1, o[DT], 0, 0, 0);
  o[8 + DT] = __builtin_amdgcn_mfma_f32_16x16x32_f16(pa[3], V1, o[8 + DT], 0, 0, 0);
  SBAR();
  if constexpr (DMA && DT < 5) { dma(DT); SBAR(); }
}
template <bool DMA, class DmaF> DEV void pv16(f4acc (&o)[16], int vb, const h8v (&pa)[4], const DmaF& dma) {
  s4v t0[4], t1[4];
  asm volatile("s_waitcnt lgkmcnt(0)" ::: "memory"); SBAR();
  pv16_issue<0>(t0, vb);
  __builtin_amdgcn_s_setprio(1);
  pv16_step<0, DMA>(o, t0, t1, vb, pa, dma); pv16_step<1, DMA>(o, t1, t0, vb, pa, dma); pv16_step<2, DMA>(o, t0, t1, vb, pa, dma); pv16_step<3, DMA>(o, t1, t0, vb, pa, dma);
  pv16_step<4, DMA>(o, t0, t1, vb, pa, dma); pv16_step<5, DMA>(o, t1, t0, vb, pa, dma); pv16_step<6, DMA>(o, t0, t1, vb, pa, dma); pv16_step<7, DMA>(o, t1, t0, vb, pa, dma);
  __builtin_amdgcn_s_setprio(0);
}
constexpr int A16_WOFF = A_VOFF + 5 * AV_SLOT;
DEV void attn16_body(const hf* __restrict__ Qb, const hf* __restrict__ Kh, const hf* __restrict__ Rh, const hf* __restrict__ Vh, hf* __restrict__ Ob, int seq, char* lds) {
  const int tid = get_tid(), wid = __builtin_amdgcn_readfirstlane(tid >> 6), lane = tid & 63, q16 = lane & 15, g = lane >> 4;
  float* wsm = (float*)(lds + A16_WOFF) + wid * 64; float* li_l = wsm; float* al_l = wsm + 32;
  float l0 = 0.f, l1 = 0.f; f4acc o[16]; h8v qr[12]; f4acc cin0 = {0.f, 0.f, 0.f, 0.f}, cin1 = {0.f, 0.f, 0.f, 0.f};
#pragma unroll
  for (int d = 0; d < 16; ++d) o[d] = (f4acc){0.f, 0.f, 0.f, 0.f};
  const hf* Qw = Qb + (size_t)(wid * 32 + q16) * DK + g * 8;
#pragma unroll
  for (int qt = 0; qt < 2; ++qt)
#pragma unroll
    for (int s = 0; s < 6; ++s) qr[qt * 6 + s] = *(const h8v*)(Qw + (size_t)(qt * 16) * DK + s * 32);
  unsigned ok0, ok2, ov0;
  { const int row = 8 * wid + (lane >> 3), c = (lane & 7) ^ ((row >> 1) & 7);
    ok0 = row * 128 + c * 8; ok2 = row * 64 + c * 8;
    ov0 = (8 * wid + ((lane & 15) >> 1)) * 128 + (lane >> 4) * 16 + (lane & 1) * 8; }
  char* kdst = lds + wid * 1024; char* vdst = lds + A_VOFF + wid * 2048;
#define A_DMA(slot, t) do { const size_t ko_ = (size_t)(t) * 64; char* kd_ = kdst + ((slot) % 3) * AK_SLOT; char* vd_ = vdst + (slot) * AV_SLOT;         \
    glds16(Kh + ko_ * 128 + ok0, kd_); glds16(Kh + ko_ * 128 + 64 + ok0, kd_ + 8192); glds16(Rh + ko_ * 64 + ok2, kd_ + 16384); glds16(Vh + ko_ * 128 + ov0, vd_); glds16(Vh + ko_ * 128 + 64 + ov0, vd_ + 1024); } while (0)
  int ko2[2];
#pragma unroll
  for (int pq = 0; pq < 2; ++pq) ko2[pq] = (int)(uintptr_t)lds + q16 * 128 + (((pq * 4 + g) ^ (q16 >> 1)) << 4);
  const int vb0 = (int)(uintptr_t)lds + A_VOFF + v16_rd_base(lane);
#define A_KB(slot) do { kb[0] = ko2[0] + (slot) * AK_SLOT; kb[1] = ko2[1] + (slot) * AK_SLOT; } while (0)
#define A_NEXT(s_) ((s_) == 2 ? 0 : (s_) + 1)
  f4acc pA[8], pB[8]; float psA, psB; h8v pa[4]; const int NT = seq / 64;
  int kb[2];
  const bool grpB = wid >= 4;
  int dt = 0, dks = 0, dvs = 0;
  auto dma_piece = [&](int i) { const size_t ko_ = (size_t)dt * 64; char* kd_ = kdst + dks * AK_SLOT; char* vd_ = vdst + dvs * AV_SLOT;
    if (i == 0) glds16(Kh + ko_ * 128 + ok0, kd_); else if (i == 1) glds16(Kh + ko_ * 128 + 64 + ok0, kd_ + 8192); else if (i == 2) glds16(Rh + ko_ * 64 + ok2, kd_ + 16384);
    else if (i == 3) glds16(Vh + ko_ * 128 + ov0, vd_); else glds16(Vh + ko_ * 128 + 64 + ov0, vd_ + 1024); };
  A_DMA(0, 0); A_DMA(1, 1);
  __syncthreads();
  A_KB(0); qk16<false>(pA, kb, qr, cin0, cin1, pB, 0.f, l0, l1, pa, dma_piece); psm16<true>(pA, cin0, cin1, l0, l1, o, al_l, pa, psA);
  __syncthreads();
  A_DMA(2, 2 < NT ? 2 : NT - 1);
  int k1 = 1, v0 = 0, kd = 0, vd = 3;
#define A_ADV() do { k1 = k1 == 2 ? 0 : k1 + 1; kd = kd == 2 ? 0 : kd + 1; v0 = v0 == 4 ? 0 : v0 + 1; vd = vd == 4 ? 0 : vd + 1; } while (0)
  for (int t = 1; t + 2 < NT; t += 2) {
    { SBAR(); A_KB(k1); qk16<true>(pB, kb, qr, cin0, cin1, pA, psA, l0, l1, pa, dma_piece); SBAR();
      if (grpB) __syncthreads();
      dt = t + 2 < NT ? t + 2 : NT - 1; dks = kd; dvs = vd;
      pv16<true>(o, vb0 + v0 * AV_SLOT, pa, dma_piece);
      psm16<false>(pB, cin0, cin1, l0, l1, o, al_l, pa, psB);
      if (!grpB) __syncthreads();
      A_ADV(); }
    { SBAR(); A_KB(k1); qk16<true>(pA, kb, qr, cin0, cin1, pB, psB, l0, l1, pa, dma_piece); SBAR();
      if (grpB) __syncthreads();
      dt = t + 3 < NT ? t + 3 : NT - 1; dks = kd; dvs = vd;
      pv16<true>(o, vb0 + v0 * AV_SLOT, pa, dma_piece);
      psm16<false>(pA, cin0, cin1, l0, l1, o, al_l, pa, psA);
      if (!grpB) __syncthreads();
      A_ADV(); }
  }
  { SBAR(); A_KB(k1); qk16<true>(pB, kb, qr, cin0, cin1, pA, psA, l0, l1, pa, dma_piece); SBAR();
    pv16<false>(o, vb0 + v0 * AV_SLOT, pa, dma_piece);
    psm16<false>(pB, cin0, cin1, l0, l1, o, al_l, pa, psB);
    { float ps1 = 0.f;
      fsm16_slice<0>(pB, psB, ps1, l0, l1, pa); fsm16_slice<1>(pB, psB, ps1, l0, l1, pa); fsm16_slice<2>(pB, psB, ps1, l0, l1, pa); fsm16_slice<3>(pB, psB, ps1, l0, l1, pa);
      fsm16_slice<4>(pB, psB, ps1, l0, l1, pa); fsm16_slice<5>(pB, psB, ps1, l0, l1, pa); fsm16_slice<6>(pB, psB, ps1, l0, l1, pa); fsm16_slice<7>(pB, psB, ps1, l0, l1, pa);
      fsm16_slice<8>(pB, psB, ps1, l0, l1, pa); fsm16_slice<9>(pB, psB, ps1, l0, l1, pa); }
    SBAR();
    A_ADV();
    pv16<false>(o, vb0 + v0 * AV_SLOT, pa, dma_piece); }
#undef A_ADV
  if (g == 0) { li_l[q16] = l0; li_l[16 + q16] = l1; } asm volatile("s_waitcnt lgkmcnt(0)" ::: "memory");
  const f4v rl0 = *(const f4v*)(li_l + 4 * g), rl1 = *(const f4v*)(li_l + 16 + 4 * g);
  hf* Ow = Ob + (size_t)(wid * 32 + 4 * g) * 1024 + q16;
#pragma unroll
  for (int i = 0; i < 4; ++i) { const float r0 = __builtin_amdgcn_rcpf(rl0[i]), r1 = __builtin_amdgcn_rcpf(rl1[i]);
#pragma unroll
    for (int d = 0; d < 8; ++d) { Ow[(size_t)i * 1024 + d * 16] = (hf)(o[d][i] * r0); Ow[(size_t)(16 + i) * 1024 + d * 16] = (hf)(o[8 + d][i] * r1); } }
  __syncthreads();
#undef A_DMA
#undef A_KB
#undef A_NEXT
}

PHASE void attn_phase(PP p, bool with_ctx, char* lds, int bid, int nblk, bool dry) {
  const hf* Q = (const hf*)(p->ws + OFF_Q); const hf* Qc = (const hf*)(p->ws + OFF_QC);
  const hf* Kb = (const hf*)(p->ws + OFF_K); const hf* KR = (const hf*)(p->ws + OFF_KR); const hf* Vb = (const hf*)(p->ws + OFF_V); hf* O = (hf*)(p->ws + OFF_ATT);
  const int nx = NB * NH * (SEQ / 256), nitems = nx + (with_ctx ? NB * NH : 0);
#if PROBE_MODE == 9
  unsigned long long ck_t0 = 0, ck_r0 = 0;
  if (bid == 0 && !dry && with_ctx) { ck_t0 = __builtin_amdgcn_s_memtime(); ck_r0 = __builtin_amdgcn_s_memrealtime(); }
#endif
  for (int it = bid; it < nitems; it += nblk) {
    const bool isx = it < nx;
    const int rnd = it >> 8, w = it & 255;
    const int bh = isx ? (w & 7) + 8 * rnd : it - nx, qb = isx ? (w >> 3) : 0;
    const int b = bh >> 3, h = bh & 7, koff = isx ? 0 : SEQ, seq = isx ? TKV : CTXL;
    const hf* Qp = isx ? Q + ((size_t)bh * SEQ + qb * 256) * DK : Qc + (size_t)bh * CTXL * DK;
    const size_t orow = isx ? (size_t)(b * SEQ + qb * 256) : (size_t)(NTOK + b * CTXL);
    if (dry) O = (hf*)(p->ws + OFF_PD);
    attn16_body(Qp, Kb + ((size_t)bh * TKV + koff) * 128, KR + ((size_t)b * TKV + koff) * 64, Vb + ((size_t)bh * TKV + koff) * DV, O + orow * 1024 + h * DV, seq, lds);
  }
#if PROBE_MODE == 9
  if (bid == 0 && !dry && with_ctx) {
    const unsigned long long t1 = __builtin_amdgcn_s_memtime(), r1 = __builtin_amdgcn_s_memrealtime();
    const unsigned long long q = ((t1 - ck_t0) * 256ull) / (r1 - ck_r0 + 1ull);
    const unsigned long long until = r1 + q * 10ull;
    while (__builtin_amdgcn_s_memrealtime() < until) __builtin_amdgcn_s_sleep(8);
  }
#endif
}

DEV void ln_row(float (&v)[16], int lane, const float* lg, const float* lb, float* xo, hf* xh, hf* ho, const float* sc, const float* sh, unsigned char* h8 = nullptr, float* hs = nullptr) {
  float s = 0.f;
#pragma unroll
  for (int i = 0; i < 16; ++i) s += v[i];
  const float mean = wave_sum(s) * (1.f / 1024.f);
  float q = 0.f;
#pragma unroll
  for (int i = 0; i < 16; ++i) { const float d = v[i] - mean; q += d * d; }
  const float rstd = rsqrtf(wave_sum(q) * (1.f / 1024.f) + LN_EPS);
#pragma unroll
  for (int hh = 0; hh < 2; ++hh) {
    const int c0 = hh * 512 + lane * 8;
    float xn[8];
#pragma unroll
    for (int i = 0; i < 8; ++i) xn[i] = (v[hh * 8 + i] - mean) * rstd * lg[c0 + i] + lb[c0 + i];
    if (xo) { *(f4v*)(xo + c0) = (f4v){xn[0], xn[1], xn[2], xn[3]}; *(f4v*)(xo + c0 + 4) = (f4v){xn[4], xn[5], xn[6], xn[7]}; }
    if (xh) { h8v t;
#pragma unroll
      for (int i = 0; i < 8; ++i) t[i] = (hf)xn[i];
      *(h8v*)(xh + c0) = t; }
    if (ho) { h8v t;
#pragma unroll
      for (int i = 0; i < 8; ++i) { const float hv = xn[i] * (1.f + sc[c0 + i]) + sh[c0 + i]; t[i] = (hf)hv; v[hh * 8 + i] = hv; }
      *(h8v*)(ho + c0) = t; }
  }
  if (h8) {
    float mx = 0.f;
#pragma unroll
    for (int i = 0; i < 16; ++i) mx = fmaxf(mx, fabsf(v[i]));
mx = wave_max(mx);
    const float scl = fmaxf(mx, 1e-30f) * (1.f / 448.f), inv = 1.f / scl;
#pragma unroll
    for (int hh = 0; hh < 2; ++hh) {
      int w0 = __builtin_amdgcn_cvt_pk_fp8_f32(v[hh * 8 + 0] * inv, v[hh * 8 + 1] * inv, 0, false); w0 = __builtin_amdgcn_cvt_pk_fp8_f32(v[hh * 8 + 2] * inv, v[hh * 8 + 3] * inv, w0, true);
      int w1 = __builtin_amdgcn_cvt_pk_fp8_f32(v[hh * 8 + 4] * inv, v[hh * 8 + 5] * inv, 0, false); w1 = __builtin_amdgcn_cvt_pk_fp8_f32(v[hh * 8 + 6] * inv, v[hh * 8 + 7] * inv, w1, true);
      typedef int i2v __attribute__((ext_vector_type(2)));
      *(i2v*)(h8 + hh * 512 + lane * 8) = (i2v){w0, w1};
    }
    if (lane == 0) *hs = scl;
  }
}
DEV const float* modp(PP p, int layer, int row, int chunk) { const int mi = row < NTOK ? (row >> 13) : 2; return (const float*)(p->ws + OFF_MOD) + ((size_t)(layer * 3 + mi) * 6 + chunk) * 1024; }

PHASE void ln_phase(PP p, int layer, int which, int M, int bid, int nblk, bool dry) {
  const int wid = get_tid() >> 6, lane = get_tid() & 63;
  hf* X = (hf*)(p->ws + OFF_X); const hf* Y = (const hf*)(p->ws + OFF_Y); hf* H = (hf*)(p->ws + OFF_H);
  const float* lg = p->in[I_LNG] + (size_t)(layer * 2 + which) * 1024; const float* lb = p->in[I_LNB] + (size_t)(layer * 2 + which) * 1024;
  const bool last = which == 1 && layer == DEPTH - 1;
  const int rstep = nblk * 8;
  for (int row0 = bid * 8 + wid; row0 < M; row0 += 2 * rstep) {
    const int row1 = row0 + rstep; const bool has1 = row1 < M; const int r1 = has1 ? row1 : row0;
    h8v yv[2][2];
#pragma unroll
    for (int hh = 0; hh < 2; ++hh) { const int c0 = hh * 512 + lane * 8;
      yv[0][hh] = *(const h8v*)(Y + (size_t)row0 * 1024 + c0);
      yv[1][hh] = *(const h8v*)(Y + (size_t)r1 * 1024 + c0); }
#pragma unroll
    for (int k = 0; k < 2; ++k) {
      const int row = k ? row1 : row0;
      if (k == 1 && !has1) break;
      const float* shn = which ? modp(p, last ? layer : layer + 1, row, 0) : modp(p, layer, row, 3);
      const float* scn = which ? modp(p, last ? layer : layer + 1, row, 1) : modp(p, layer, row, 4);
      float v[16];
#pragma unroll
      for (int hh = 0; hh < 2; ++hh) { const int c0 = hh * 512 + lane * 8;
#pragma unroll
        for (int i = 0; i < 8; ++i) v[hh * 8 + i] = (float)yv[k][hh][i]; }
      float* xo = (last && !dry) ? p->out + (size_t)row * 1024 : (float*)nullptr;
      hf* xh = dry ? (hf*)(p->ws + OFF_PD) + (size_t)row * 1024 : (last ? (hf*)nullptr : X + (size_t)row * 1024);
      hf* ho = dry ? (hf*)(p->ws + OFF_Z) + (size_t)row * 1024 : (last ? (hf*)nullptr : H + (size_t)row * 1024);
      unsigned char* h8 = (which == 0 && !dry) ? (unsigned char*)(p->ws + OFF_H8) + (size_t)row * 1024 : (unsigned char*)nullptr;
      ln_row(v, lane, lg, lb, xo, xh, ho, scn, shn, h8, (float*)(p->ws + OFF_HS) + row);
    }
  }
}

PHASE void pool_phase(PP p, int M, int bid, int nblk) {
  const hf* Z = (const hf*)(p->ws + OFF_Z); hf* P = (hf*)(p->ws + OFF_ATT);
  const long total = (long)(M / 16) * 128;
  for (long idx = (long)bid * NTHR + get_tid(); idx < total; idx += (long)nblk * NTHR) {
    const int run = (int)(idx >> 7), ch = (int)(idx & 127), g = ch >> 5, half = 1 << g;
    const int row0 = run * 16;
    int base, L, t0;
    if (row0 < NTOK) { base = row0 & ~8191; L = SEQ; t0 = row0 & 8191; } else { const int rr = row0 - NTOK; base = NTOK + (rr & ~255); L = CTXL; t0 = rr & 255; }
    const hf* Zc = Z + (size_t)base * 1024 + ch * 8;
    float s[8] = {0, 0, 0, 0, 0, 0, 0, 0};
    { const int lo = max(t0 - half, 0), hi = min(t0 + half, L);
      for (int u = lo; u < hi; ++u) { const h8v z = *(const h8v*)(Zc + (size_t)u * 1024);
#pragma unroll
        for (int i = 0; i < 8; ++i) s[i] += (float)z[i]; } }
#pragma unroll 4
    for (int k = 0; k < 16; ++k) {
      const int t = t0 + k, lo = max(t - half, 0), hi = min(t + half, L);
      const h8v zs = *(const h8v*)(Zc + (size_t)t * 1024); const float inv = 1.f / (float)(hi - lo);
      h8v o;
#pragma unroll
      for (int i = 0; i < 8; ++i) o[i] = (hf)(s[i] * inv - (float)zs[i]);
      *(h8v*)(P + (size_t)(base + t) * 1024 + ch * 8) = o;
      if (k < 15) {
        if (t + half < L) { const h8v z = *(const h8v*)(Zc + (size_t)(t + half) * 1024);
#pragma unroll
          for (int i = 0; i < 8; ++i) s[i] += (float)z[i]; }
        if (t - half >= 0) { const h8v z = *(const h8v*)(Zc + (size_t)(t - half) * 1024);
#pragma unroll
          for (int i = 0; i < 8; ++i) s[i] -= (float)z[i]; }
      }
    }
  }
}

DEV unsigned pack_key(float f, unsigned id, unsigned mask) { const unsigned u = __float_as_uint(f); const unsigned m = u ^ ((unsigned)((int)u >> 31) | 0x80000000u); return (m & ~mask) | id; }
DEV float unpack_val(unsigned key, unsigned mask) { const unsigned m = key & ~mask; const unsigned u = (m & 0x80000000u) ? (m ^ 0x80000000u) : ~m; return __uint_as_float(u); }
DEV void cas(unsigned& a, unsigned& b) { const unsigned mx = a > b ? a : b, mn = a > b ? b : a; a = mx; b = mn; }
template <int N> DEV void bitonic_sort_desc(unsigned (&k)[N]) {
#pragma unroll
  for (int size = 2; size <= N; size <<= 1)
#pragma unroll
    for (int stride = size >> 1; stride > 0; stride >>= 1)
#pragma unroll
      for (int i = 0; i < N; ++i) { const int j = i ^ stride; if (j > i) { if ((i & size) == 0) cas(k[i], k[j]); else cas(k[j], k[i]); } }
}
DEV void sort16_desc(unsigned (&k)[16]) { cas(k[0], k[1]); cas(k[2], k[3]); cas(k[0], k[2]); cas(k[1], k[3]); cas(k[1], k[2]); cas(k[4], k[5]); cas(k[6], k[7]); cas(k[4], k[6]); cas(k[5], k[7]); cas(k[5], k[6]); cas(k[0], k[4]); cas(k[2], k[6]); cas(k[2], k[4]); cas(k[1], k[5]); cas(k[3], k[7]); cas(k[3], k[5]); cas(k[1], k[2]); cas(k[3], k[4]); cas(k[5], k[6]); cas(k[8], k[9]); cas(k[10], k[11]); cas(k[8], k[10]); cas(k[9], k[11]); cas(k[9], k[10]); cas(k[12], k[13]); cas(k[14], k[15]); cas(k[12], k[14]); cas(k[13], k[15]); cas(k[13], k[14]); cas(k[8], k[12]); cas(k[10], k[14]); cas(k[10], k[12]); cas(k[9], k[13]); cas(k[11], k[15]); cas(k[11], k[13]); cas(k[9], k[10]); cas(k[11], k[12]); cas(k[13], k[14]); cas(k[0], k[8]); cas(k[4], k[12]); cas(k[4], k[8]); cas(k[2], k[10]); cas(k[6], k[14]); cas(k[6], k[10]); cas(k[2], k[4]); cas(k[6], k[8]); cas(k[10], k[12]); cas(k[1], k[9]); cas(k[5], k[13]); cas(k[5], k[9]); cas(k[3], k[11]); cas(k[7], k[15]); cas(k[7], k[11]); cas(k[3], k[5]); cas(k[7], k[9]); cas(k[11], k[13]); cas(k[1], k[2]); cas(k[3], k[4]); cas(k[5], k[6]); cas(k[7], k[8]); cas(k[9], k[10]); cas(k[11], k[12]); cas(k[13], k[14]); }
DEV void bitonic_merge16(unsigned (&k)[16]) {
#pragma unroll
  for (int stride = 8; stride > 0; stride >>= 1)
#pragma unroll
    for (int i = 0; i < 16; ++i) { const int j = i ^ stride; if (j > i) cas(k[i], k[j]); }
}
DEV void merge_top16(unsigned (&a)[16], const unsigned (&b)[16]) {
#pragma unroll
  for (int i = 0; i < 16; ++i) { const unsigned y = b[15 - i]; a[i] = a[i] > y ? a[i] : y; }
  bitonic_merge16(a);
}
DEV void local_top16(const f16v (&acc)[4], int hi, unsigned (&outk)[16]) {
  unsigned g[16], t[16];
#pragma unroll
  for (int mt = 0; mt < 4; ++mt) {
#pragma unroll
    for (int r = 0; r < 16; ++r) t[r] = pack_key(acc[mt][r], (unsigned)(mt * 32 + (r & 3) + 8 * (r >> 2) + 4 * hi), 0x7Fu);
    sort16_desc(t);
    if (mt == 0) {
#pragma unroll
      for (int r = 0; r < 16; ++r) g[r] = t[r];
    } else merge_top16(g, t);
  }
#pragma unroll
  for (int r = 0; r < 16; ++r) outk[r] = g[r];
}

PHASE void topk_phase(PP p, int layer, int M, char* lds, int bid, int nblk) {
  const int tid = get_tid(), wid = tid >> 6, lane = tid & 63, r32 = lane & 31, hi = lane >> 5;
  const hf* PQ = (const hf*)(p->ws + OFF_PQ);
  unsigned short* IDX = (unsigned short*)(p->ws + OFF_IDX); float* G = (float*)(p->ws + OFF_G);
  const int h = bid & 7, nper = nblk >> 3;
  char* Klds = lds;
  unsigned char* lut = (unsigned char*)lds + 65536 + wid * 2048 + lane * 32;
  if (bid < nper * 8) {
#pragma unroll
    for (int half = 0; half < 2; ++half) {
      const hf* Kg = (const hf*)(p->ws + (half ? OFF_K2 : OFF_K1)) + ((size_t)(layer * NH + h) * 128) * 128;
#pragma unroll
      for (int q = 0; q < 4; ++q) { const int cidx = tid + q * NTHR, row = cidx >> 4, ch = cidx & 15;
        *(h8v*)(Klds + half * 32768 + row * 256 + ((ch ^ (row & 15)) << 4)) = *(const h8v*)(Kg + (size_t)row * 128 + ch * 8); }
    }
  }
  char* SCl = lds + 81920;
  if (bid < nper * 8) {
    const u4v* sg = (const u4v*)(p->ws + OFF_SUVH + (size_t)layer * NEXP * 4);
#pragma unroll
    for (int q = 0; q < 8; ++q) *(u4v*)(SCl + (size_t)(tid + q * NTHR) * 16) = sg[tid + q * NTHR];
  }
  __syncthreads();
  for (int mt256 = bid >> 3; mt256 < M / 256 && bid < nper * 8; mt256 += nper) {
    const int token = mt256 * 256 + wid * 32 + r32;
    unsigned A1[16], A2[16];
#pragma unroll
    for (int half = 0; half < 2; ++half) {
      f16v acc[4];
#pragma unroll
      for (int m = 0; m < 4; ++m)
#pragma unroll
        for (int r = 0; r < 16; ++r) acc[m][r] = 0.f;
      const hf* qp = PQ + (size_t)token * 2048 + h * 256 + half * 128 + hi * 8;
      h8v bq[8];
#pragma unroll
      for (int ks = 0; ks < 8; ++ks) bq[ks] = *(const h8v*)(qp + ks * 16);
#pragma unroll
      for (int ks = 0; ks < 8; ++ks) {
#pragma unroll
        for (int m = 0; m < 4; ++m) {
          const int row = m * 32 + r32;
          const h8v ak = *(const h8v*)(Klds + half * 32768 + row * 256 + (((ks * 2 + hi) ^ (row & 15)) << 4));
          acc[m] = __builtin_amdgcn_mfma_f32_32x32x16_f16(ak, bq[ks], acc[m], 0, 0, 0);
        }
      }
      if (half == 0) local_top16(acc, hi, A1); else local_top16(acc, hi, A2);
    }
    unsigned L[16];
    {
      unsigned Bq[16];
#pragma unroll
      for (int i = 0; i < 16; ++i) { auto rr = __builtin_amdgcn_permlane32_swap(A1[i], A2[i], false, false); L[i] = rr[0]; Bq[i] = rr[1]; }
      merge_top16(L, Bq);
    }
    float f1[16], f2[16];
    {
      unsigned pk1 = 0, pk2 = 0, w1[4], w2[4];
#pragma unroll
      for (int i = 0; i < 16; ++i) {
        auto rr = __builtin_amdgcn_permlane32_swap(L[i], L[i], false, false);
        const unsigned k1 = rr[0], k2 = rr[1];
        f1[i] = unpack_val(k1, 0x7Fu); f2[i] = unpack_val(k2, 0x7Fu);
        pk1 |= (k1 & 0x7Fu) << (8 * (i & 3)); pk2 |= (k2 & 0x7Fu) << (8 * (i & 3));
        if ((i & 3) == 3) { w1[i >> 2] = pk1; w2[i >> 2] = pk2; pk1 = 0; pk2 = 0; }
      }
      *(u4v*)(lut) = (u4v){w1[0], w1[1], w1[2], w1[3]}; *(u4v*)(lut + 16) = (u4v){w2[0], w2[1], w2[2], w2[3]};
    }
    unsigned T[16];
    {
      unsigned t[16];
#pragma unroll
      for (int b = 0; b < 16; ++b) T[b] = pack_key(f1[0] + f2[b], 255u - (unsigned)b, 0xFFu);
#pragma unroll
      for (int b = 0; b < 16; ++b) t[b] = b < 8 ? pack_key(f1[1] + f2[b], 255u - (unsigned)(16 + b), 0xFFu) : 0u;
      merge_top16(T, t);
      unsigned u[16];
      { int n = 0;
#pragma unroll
        for (int a = 2; a < 7; ++a)
#pragma unroll
          for (int b = 0; b < 16; ++b) if ((a + 1) * (b + 1) <= 16) { u[n] = pack_key(f1[a] + f2[b], 255u - (unsigned)(a * 16 + b), 0xFFu); ++n; } }
      sort16_desc(u);
      { int n = 0;
#pragma unroll
        for (int a = 7; a < 16; ++a)
#pragma unroll
          for (int b = 0; b < 16; ++b) if ((a + 1) * (b + 1) <= 16) { t[n] = pack_key(f1[a] + f2[b], 255u - (unsigned)(a * 16 + b), 0xFFu); ++n; }
#pragma unroll
        for (int i = 10; i < 16; ++i) t[i] = 0u; }
      sort16_desc(t);
      merge_top16(u, t);
      merge_top16(T, u);
    }
    float sv[16]; const float mx = unpack_val(T[0], 0xFFu); float den = 0.f;
#pragma unroll
    for (int i = 0; i < 16; ++i) { sv[i] = __expf(unpack_val(T[i], 0xFFu) - mx); den += sv[i]; }
    const float rden = 1.f / den;
    asm volatile("s_waitcnt lgkmcnt(0)" ::: "memory");
    {
      unsigned short* ip = IDX + (size_t)token * 128 + h * 16 + 8 * hi; float* gp = G + (size_t)token * 128 + h * 16 + 8 * hi;
      float* sp = (float*)(p->ws + OFF_SUT) + (size_t)token * 128 + h * 16 + 8 * hi;
      int ev_[8]; float gt_[8]; const unsigned hm_ = hi ? 0xFFFFFFFFu : 0u;
#pragma unroll
      for (int i = 0; i < 8; ++i) {
        const unsigned key = (T[8 + i] & hm_) | (T[i] & ~hm_);
        const unsigned id = 255u - (key & 0xFFu); const int a = id >> 4, b = id & 15;
        const int i1 = lut[a], i2 = lut[16 + b];
        ev_[i] = i1 * 128 + i2; gt_[i] = __uint_as_float((__float_as_uint(sv[8 + i]) & hm_) | (__float_as_uint(sv[i]) & ~hm_)) * rden;
      }
      f2v sc_[8];
#pragma unroll
      for (int i = 0; i < 8; ++i) { const h2v t_ = *(const h2v*)(SCl + ev_[i] * 4); sc_[i] = (f2v){(float)t_[0], (float)t_[1]}; }
      { typedef unsigned short us8 __attribute__((ext_vector_type(8))); us8 e8;
#pragma unroll
        for (int i = 0; i < 8; ++i) e8[i] = (unsigned short)ev_[i];
        *(us8*)ip = e8; }
      *(f4v*)gp = (f4v){gt_[0] * sc_[0][1], gt_[1] * sc_[1][1], gt_[2] * sc_[2][1], gt_[3] * sc_[3][1]}; *(f4v*)(gp + 4) = (f4v){gt_[4] * sc_[4][1], gt_[5] * sc_[5][1], gt_[6] * sc_[6][1], gt_[7] * sc_[7][1]};
      *(f4v*)sp = (f4v){sc_[0][0], sc_[1][0], sc_[2][0], sc_[3][0]}; *(f4v*)(sp + 4) = (f4v){sc_[4][0], sc_[5][0], sc_[6][0], sc_[7][0]};
    }
  }
}

DEV float gelu_exact(float x) { return 0.5f * x * (1.f + erff(x * 0.7071067811865476f)); }
DEV float erf_as(float z) {
  const float az = fabsf(z), t = __builtin_amdgcn_rcpf(fmaf(0.3275911f, az, 1.f));
  float q = fmaf(1.061405429f, t, -1.453152027f); q = fmaf(q, t, 1.421413741f); q = fmaf(q, t, -0.284496736f); q = fmaf(q, t, 0.254829592f); q *= t;
  const float r = 1.f - q * __builtin_amdgcn_exp2f(-az * az * 1.4426950408889634f);
  return __builtin_copysignf(r, z);
}
DEV float gelu_as(float x) { return 0.5f * x * (1.f + erf_as(x * 0.7071067811865476f)); }

struct XRole { int lx, nlx, rank, cnt; };
constexpr int CTL_WORDS = 8;
#define LAS3 __attribute__((address_space(3)))
DEV XRole get_role(PP p, char* lds, int bid, int nblk, bool one_launch) {
  XRole r;
  if (!one_launch) { r.lx = bid & 7; r.nlx = 8; r.rank = bid >> 3; r.cnt = (nblk + 7 - (bid & 7)) >> 3; return r; }
  volatile LAS3 unsigned* st = (volatile LAS3 unsigned*)(lds + LDS_TOTAL);
  if (__builtin_amdgcn_workitem_id_x() == 0 && st[7] == 0u) {
    unsigned* bar = (unsigned*)(p->ws + OFF_BAR); const unsigned x = st[3];
    unsigned lx = 0, nlx = 0, cnt = 1;
    for (unsigned j = 0; j < 16; ++j) { const unsigned c = __hip_atomic_load(&bar[256 + 64 * j], __ATOMIC_RELAXED, __HIP_MEMORY_SCOPE_AGENT); if (c > 0u) { if (j < x) ++lx; ++nlx; } if (j == x) cnt = c > 0u ? c : 1u; }
    st[4] = lx; st[5] = nlx > 0u ? nlx : 1u; st[6] = cnt; st[7] = 1u;
  }
  __syncthreads();
  r.lx = __builtin_amdgcn_readfirstlane((int)st[4]); r.nlx = __builtin_amdgcn_readfirstlane((int)st[5]); r.cnt = __builtin_amdgcn_readfirstlane((int)st[6]); r.rank = __builtin_amdgcn_readfirstlane((int)st[2]);
  return r;
}
DEV void fp8x16_to_f32(u4v d, float (&o)[16]) {
#pragma unroll
  for (int q = 0; q < 4; ++q) { const f2v lo = __builtin_amdgcn_cvt_pk_f32_fp8((int)d[q], false), hi = __builtin_amdgcn_cvt_pk_f32_fp8((int)d[q], true); o[4 * q] = lo[0]; o[4 * q + 1] = lo[1]; o[4 * q + 2] = hi[0]; o[4 * q + 3] = hi[1]; }
}
DEV void* uniform_ptr(const void* q) { const unsigned long long b = (unsigned long long)q; const unsigned lo = __builtin_amdgcn_readfirstlane((unsigned)b), hi = __builtin_amdgcn_readfirstlane((unsigned)(b >> 32)); return (void*)(((unsigned long long)hi << 32) | lo); }
typedef int i8v __attribute__((ext_vector_type(8)));
PHASE void peer_u_phase_dma(PP p, int layer, int M, const XRole r, char* lds, int bid, int nblk) {
  const int tid = get_tid(), wid = __builtin_amdgcn_readfirstlane(tid >> 6), lane = tid & 63, a = lane >> 3, c = lane & 7, rr = lane & 15, kg = lane >> 4;
  const unsigned char* H8 = (const unsigned char*)(p->ws + OFF_H8); const unsigned short* IDX = (const unsigned short*)(p->ws + OFF_IDX);
  const int P = r.nlx < 4 ? r.nlx : 4, pidx = r.lx % P, np = (r.nlx - pidx + P - 1) / P, gi = r.lx / P;
  const int t0 = gi + np * (r.rank * 8 + wid), step = np * r.cnt * 8;
  char* tlp = lds + wid * 16384; const int tl = (int)(uintptr_t)tlp;
  const int rb0 = tl + rr * 1024 + ((kg ^ (rr & 7)) << 4), rb1 = rb0 ^ 64;
  for (int s = pidx; s < 4; s += P) {
    const unsigned char* tab = (const unsigned char*)uniform_ptr(p->ws + OFF_U8 + ((size_t)(layer * 4 + s) * NEXP) * 128);
    hf* PDs = (hf*)(p->ws + OFF_PD) + (size_t)s * MALL * 128 + kg * 4;
    const unsigned char* Hs = H8 + s * 256 + kg * 16;
    u4v eA[2]; u4v hN[4];
#define UD_LOADE(tok) do { const u4v* ip_ = (const u4v*)(IDX + (size_t)(tok) * 128 + a * 16); eA[0] = ip_[0]; eA[1] = ip_[1]; } while (0)
#define UD_DMA() do { _Pragma("unroll") for (int i = 0; i < 16; ++i) { const unsigned e_ = (eA[i >> 3][(i >> 1) & 3] >> (16 * (i & 1))) & 0xFFFFu;                  \
      glds16((const hf*)(tab + (size_t)e_ * 128 + ((c ^ (i & 7)) << 4)), tlp + i * 1024); } } while (0)
#define UD_LOADH(tok) do { const u4v* hp_ = (const u4v*)(Hs + (size_t)(tok) * 1024); hN[0] = hp_[0]; hN[1] = hp_[4]; hN[2] = hp_[8]; hN[3] = hp_[12]; } while (0)
    if (t0 < M) { UD_LOADE(t0); UD_DMA(); UD_LOADH(t0); if (t0 + step < M) UD_LOADE(t0 + step); }
    for (int token = t0; token < M; token += step) {
      asm volatile("s_waitcnt vmcnt(0) lgkmcnt(0)" ::: "memory");
      const i8v b0_ = {(int)hN[0][0], (int)hN[0][1], (int)hN[0][2], (int)hN[0][3], (int)hN[1][0], (int)hN[1][1], (int)hN[1][2], (int)hN[1][3]};
      const i8v b1_ = {(int)hN[2][0], (int)hN[2][1], (int)hN[2][2], (int)hN[2][3], (int)hN[3][0], (int)hN[3][1], (int)hN[3][2], (int)hN[3][3]};
      u4v x0_[8], x1_[8];
#pragma unroll
      for (int j = 0; j < 8; ++j) { x0_[j] = *(const u4v __attribute__((address_space(3)))*)(rb0 + j * 128); x1_[j] = *(const u4v __attribute__((address_space(3)))*)(rb1 + j * 128); }
      asm volatile("s_waitcnt lgkmcnt(0)" ::: "memory");
      if (token + step < M) { UD_DMA(); UD_LOADH(token + step); if (token + 2 * step < M) UD_LOADE(token + 2 * step); }
#pragma unroll
      for (int j = 0; j < 8; ++j) {
        const i8v a0_ = {(int)x0_[j][0], (int)x0_[j][1], (int)x0_[j][2], (int)x0_[j][3], 0, 0, 0, 0};
        const i8v a1_ = {(int)x1_[j][0], (int)x1_[j][1], (int)x1_[j][2], (int)x1_[j][3], 0, 0, 0, 0};
        f4acc acc_ = __builtin_amdgcn_mfma_scale_f32_16x16x128_f8f6f4(a0_, b0_, (f4acc){0.f, 0.f, 0.f, 0.f}, 4, 0, 0, 0x7F7F7F7F, 0, 0x7F7F7F7F);
        acc_ = __builtin_amdgcn_mfma_scale_f32_16x16x128_f8f6f4(a1_, b1_, acc_, 4, 0, 0, 0x7F7F7F7F, 0, 0x7F7F7F7F);
        if (rr == j) *(h4v*)(PDs + (size_t)token * 128 + j * 16) = pack4(acc_[0] * 0.0625f, acc_[1] * 0.0625f, acc_[2] * 0.0625f, acc_[3] * 0.0625f);
      }
    }
#undef UD_LOADE
#undef UD_DMA
#undef UD_LOADH
  }
}
typedef int i2v_ __attribute__((ext_vector_type(2)));
PHASE void peer_v_phase_dma(PP p, int layer, int M, const XRole r, char* lds, int bid, int nblk) {
  const int tid = get_tid(), wid = __builtin_amdgcn_readfirstlane(tid >> 6), lane = tid & 63, a = lane >> 3, c = lane & 7, n = lane & 15, kg = lane >> 4;
  const unsigned short* IDX = (const unsigned short*)(p->ws + OFF_IDX); const hf* PD = (const hf*)(p->ws + OFF_PD); const float* G = (const float*)(p->ws + OFF_G); const float* HS = (const float*)(p->ws + OFF_HS);
  const float* SUT = (const float*)(p->ws + OFF_SUT);
  const int wl = (int)(uintptr_t)lds + 131072 + wid * 128;
  const int wpos = 16 * (lane & 7) + (lane >> 3);
  const int P = r.nlx < 4 ? r.nlx : 4, pidx = r.lx % P, np = (r.nlx - pidx + P - 1) / P, gi = r.lx / P;
  const int t0 = gi + np * (r.rank * 8 + wid), step = np * r.cnt * 8;
  char* tlp = lds + wid * 16384; const int tl = (int)(uintptr_t)tlp;
  const int sc0 = (c ^ ((a >> 1) & 7)) * 16, sc1 = (c ^ ((4 + (a >> 1)) & 7)) * 16;
  const int rrow = tl + (32 * kg + n) * 128, nx = (n >> 1) << 4;
  for (int s = pidx; s < 4; s += P) {
    const unsigned char* tab = (const unsigned char*)uniform_ptr(p->ws + OFF_V8 + ((size_t)(layer * 4 + s) * NEXP) * 128);
    const int dcol = s * 256 + (kg * 4 + (n & 3)) * 16 + (n >> 2) * 4;
    hf* OUTs = (hf*)(p->ws + OFF_Y) + dcol; const hf* Xs = (const hf*)(p->ws + OFF_X) + dcol; const float* g2p = (const float*)(p->ws + OFF_MOD) + ((size_t)(layer * 3) * 6 + 5) * 1024 + dcol;
    u4v eA[2]; float hsX = 0.f; f2v gX, suX; h2v pdX[4];
#define VD_LOADE(tok) do { const u4v* ip_ = (const u4v*)(IDX + (size_t)(tok) * 128 + a * 16); eA[0] = ip_[0]; eA[1] = ip_[1]; } while (0)
#define VD_DMA() do { _Pragma("unroll") for (int i = 0; i < 16; ++i) { const unsigned e_ = (eA[i >> 3][(i >> 1) & 3] >> (16 * (i & 1))) & 0xFFFFu;                  \
      glds16((const hf*)(tab + (size_t)e_ * 128 + ((i & 1) ? sc1 : sc0)), tlp + i * 1024); } } while (0)
#define VD_WLOAD(tok) do { suX = *(const f2v*)(SUT + (size_t)(tok) * 128 + 2 * lane);                                                                  \
    gX = *(const f2v*)(G + (size_t)(tok) * 128 + 2 * lane); hsX = HS[tok];                                                                            \
    _Pragma("unroll") for (int k = 0; k < 4; ++k) pdX[k] = *(const h2v*)(PD + (size_t)k * MALL * 128 + (size_t)(tok) * 128 + 2 * lane); } while (0)
#define VD_WCALC(SSO) do { const float h16_ = 16.f * hsX;                                                  \
      const float s0_ = ((float)pdX[0][0] + (float)pdX[1][0]) + ((float)pdX[2][0] + (float)pdX[3][0]), s1_ = ((float)pdX[0][1] + (float)pdX[1][1]) + ((float)pdX[2][1] + (float)pdX[3][1]); \
      const float w0_ = gX[0] * gelu_as(suX[0] * h16_ * s0_), w1_ = gX[1] * gelu_as(suX[1] * h16_ * s1_);                                            \
      float mx_ = fmaxf(fabsf(w0_), fabsf(w1_));                                                                                                      \
      mx_ = fmaxf(mx_, dpp_mov<0xB1>(mx_)); mx_ = fmaxf(mx_, dpp_mov<0x4E>(mx_)); mx_ = fmaxf(mx_, dpp_mov<0x141>(mx_)); mx_ = fmaxf(mx_, dpp_mov<0x140>(mx_));    \
      { auto r_ = __builtin_amdgcn_permlane16_swap(__float_as_uint(mx_), __float_as_uint(mx_), false, false); mx_ = fmaxf(__uint_as_float(r_[0]), __uint_as_float(r_[1]));  \
        r_ = __builtin_amdgcn_permlane32_swap(__float_as_uint(mx_), __float_as_uint(mx_), false, false); mx_ = fmaxf(__uint_as_float(r_[0]), __uint_as_float(r_[1])); }      \
      SSO = fmaxf(mx_, 1e-30f) * (1.f / 448.f); const float inv_ = 1.f / SSO;                                                                         \
      const unsigned wq_ = (unsigned)__builtin_amdgcn_cvt_pk_fp8_f32(w0_ * inv_, w1_ * inv_, 0, false);                                               \
      *(unsigned char __attribute__((address_space(3)))*)(wl + wpos) = (unsigned char)wq_;                                              \
      *(unsigned char __attribute__((address_space(3)))*)(wl + wpos + 8) = (unsigned char)(wq_ >> 8); } while (0)
#define VD_TRI(b) { asm volatile("ds_read_b64_tr_b4 %0, %1" : "=&v"(ta_[(b) & 3]) : "v"(rrow + (((((b) >> 1) << 4) ^ nx)) + ((b) & 1) * 8) : "memory");            \
                    asm volatile("ds_read_b64_tr_b4 %0, %1" : "=&v"(tb_[(b) & 3]) : "v"(rrow + 2048 + (((((b) >> 1) << 4) ^ nx)) + ((b) & 1) * 8) : "memory"); }
#define VD_STEP(b, NW) { asm volatile("s_waitcnt lgkmcnt(" #NW ")" ::: "memory"); __builtin_amdgcn_sched_barrier(0);                                  \
      const i8v bb_ = {ta_[(b) & 3][0], ta_[(b) & 3][1], tb_[(b) & 3][0], tb_[(b) & 3][1], 0, 0, 0, 0};                                                \
      const f4acc acc_ = __builtin_amdgcn_mfma_scale_f32_16x16x128_f8f6f4(aw_, bb_, (f4acc){0.f, 0.f, 0.f, 0.f}, 0, 4, 0, 0x7F7F7F7F, 0, 0x7F7F7F7F);  \
      __builtin_amdgcn_sched_barrier(0);                                                                                                              \
      if ((b) + 4 < 16) VD_TRI(((b) + 4) & 15)                                                                                                        \
      in_[(b) & 3] = (kg == ((b) >> 2)) ? acc_[0] : in_[(b) & 3]; }
    if (t0 < M) { VD_LOADE(t0); VD_DMA(); VD_WLOAD(t0); if (t0 + step < M) VD_LOADE(t0 + step); }
    for (int token = t0; token < M; token += step) {
      float SS;
      VD_WCALC(SS);
      asm volatile("s_waitcnt vmcnt(0) lgkmcnt(0)" ::: "memory");
      if (token + step < M) VD_WLOAD(token + step);
      const u4v WW0_ = *(const u4v __attribute__((address_space(3)))*)(wl + kg * 16), WW1_ = *(const u4v __attribute__((address_space(3)))*)(wl + 64 + kg * 16);
      asm volatile("s_waitcnt lgkmcnt(0)" ::: "memory");
      const i8v aw_ = {(int)WW0_[0], (int)WW0_[1], (int)WW0_[2], (int)WW0_[3], (int)WW1_[0], (int)WW1_[1], (int)WW1_[2], (int)WW1_[3]};
      float in_[4] = {0.f, 0.f, 0.f, 0.f}; i2v_ ta_[16], tb_[16];
#define VD_RD(b) { asm volatile("ds_read_b64_tr_b4 %0, %1" : "=&v"(ta_[b]) : "v"(rrow + (((((b) >> 1) << 4) ^ nx)) + ((b) & 1) * 8) : "memory");            \
                   asm volatile("ds_read_b64_tr_b4 %0, %1" : "=&v"(tb_[b]) : "v"(rrow + 2048 + (((((b) >> 1) << 4) ^ nx)) + ((b) & 1) * 8) : "memory"); }
      VD_RD(0) VD_RD(1) VD_RD(2) VD_RD(3) VD_RD(4) VD_RD(5) VD_RD(6) VD_RD(7) VD_RD(8) VD_RD(9) VD_RD(10) VD_RD(11) VD_RD(12) VD_RD(13) VD_RD(14) VD_RD(15)
#undef VD_RD
      asm volatile("s_waitcnt lgkmcnt(0)" ::: "memory"); __builtin_amdgcn_sched_barrier(0);
      if (token + step < M) { VD_DMA(); if (token + 2 * step < M) VD_LOADE(token + 2 * step); }
#pragma unroll
      for (int b = 0; b < 16; ++b) {
        const i8v bb_ = {ta_[b][0], ta_[b][1], tb_[b][0], tb_[b][1], 0, 0, 0, 0};
        const f4acc acc_ = __builtin_amdgcn_mfma_scale_f32_16x16x128_f8f6f4(aw_, bb_, (f4acc){0.f, 0.f, 0.f, 0.f}, 0, 4, 0, 0x7F7F7F7F, 0, 0x7F7F7F7F);
        in_[b & 3] = (kg == (b >> 2)) ? acc_[0] : in_[b & 3];
      }
      { const bool l0_ = (n & 1) != 0, l1_ = (n & 2) != 0;
#pragma unroll
        for (int k = 0; k < 4; k += 2) { const float x_ = l0_ ? in_[k] : in_[k + 1]; const float y_ = dpp_mov<0xB1>(x_); if (l0_) in_[k] = y_; else in_[k + 1] = y_; }
#pragma unroll
        for (int k = 0; k < 2; ++k) { const float x_ = l1_ ? in_[k] : in_[k + 2]; const float y_ = dpp_mov<0x4E>(x_); if (l1_) in_[k] = y_; else in_[k + 2] = y_; } }
      { const h4v x_ = *(const h4v*)(Xs + (size_t)token * 1024); const f4v g_ = *(const f4v*)(g2p + row_mi(token) * 6144);
        *(h4v*)(OUTs + (size_t)token * 1024) = pack4(ALPHA * (float)x_[0] + g_[0] * in_[0] * SS, ALPHA * (float)x_[1] + g_[1] * in_[1] * SS, ALPHA * (float)x_[2] + g_[2] * in_[2] * SS, ALPHA * (float)x_[3] + g_[3] * in_[3] * SS); }
    }
#undef VD_LOADE
#undef VD_DMA
#undef VD_WLOAD
#undef VD_WCALC
#undef VD_TRI
#undef VD_STEP
  }
}
DEV void transpose_tiles(const TJob j, int tile0, int ntl, char* lds) {
  float* T = (float*)lds;
  const int tid = get_tid();
  const int ntn = j.Npad / 64;
  f4v v[4][2];
#pragma unroll
  for (int q = 0; q < 4; ++q) {
    const int tile = tile0 + (q < ntl ? q : 0), kt = tile / ntn, nt = tile - kt * ntn, k0 = kt * 64, n0 = nt * 64;
#pragma unroll
    for (int jj = 0; jj < 2; ++jj) {
      const int kl = (tid >> 4) + 32 * jj, nl = (tid & 15) * 4;
      v[q][jj] = (f4v){0.f, 0.f, 0.f, 0.f};
      if (q < ntl && n0 + nl < j.N) v[q][jj] = *(const f4v*)(j.src + (size_t)(k0 + kl) * j.N + n0 + nl);
    }
  }
#pragma unroll
  for (int q = 0; q < 4; ++q) {
    const int tile = tile0 + (q < ntl ? q : 0), kt = tile / ntn, k0 = kt * 64;
#pragma unroll
    for (int jj = 0; jj < 2; ++jj) {
      const int kl = (tid >> 4) + 32 * jj, nl = (tid & 15) * 4;
      const float gsc = j.gs ? j.gs[k0 + kl] : 1.f;
#pragma unroll
      for (int i = 0; i < 4; ++i) T[q * 4160 + (nl + i) * 65 + kl] = v[q][jj][i] * gsc;
    }
  }
  __syncthreads();
#pragma unroll
  for (int q = 0; q < 4; ++q) {
    if (q < ntl) {
      const int tile = tile0 + q, kt = tile / ntn, nt = tile - kt * ntn, k0 = kt * 64, n0 = nt * 64;
      const int nl = tid >> 3, kc = (tid & 7) * 8; h8v o;
#pragma unroll
      for (int i = 0; i < 8; ++i) o[i] = (hf)T[q * 4160 + nl * 65 + kc + i];
      *(h8v*)(j.dst + (size_t)(n0 + nl) * j.K + k0 + kc) = o;
    }
  }
  __syncthreads();
}
DEV void convert_f16(const float* __restrict__ src, hf* __restrict__ dst, long n8, int bid, int nblk) {
  for (long i = (long)bid * NTHR + get_tid(); i < n8; i += (long)nblk * NTHR) {
    const f4v a = *(const f4v*)(src + i * 8), b = *(const f4v*)(src + i * 8 + 4);
    h8v o = {(hf)a[0], (hf)a[1], (hf)a[2], (hf)a[3], (hf)b[0], (hf)b[1], (hf)b[2], (hf)b[3]};
    *(h8v*)(dst + i * 8) = o;
  }
}
PHASE void prologue_a(PP p, char* lds, int bid, int nblk) {
  const int tid = get_tid(), wid = tid >> 6, lane = tid & 63;
  {
    float* sin_ = (float*)lds;
    float* red = (float*)lds + 3072;
    for (int i = tid; i < 3072; i += NTHR) { const int v = i >> 10, k = i & 1023; const float x = v < 2 ? p->in[I_C][v * 1024 + k] : p->in[I_CCTX][k]; sin_[i] = silu(x); }
    __syncthreads();
    float* MOD = (float*)(p->ws + OFF_MOD);
    for (int it = bid; it < 4 * 96; it += nblk) {
      const int l = it / 96, cg = it - l * 96, col = cg * 64 + lane;
      const float* w = p->in[I_WMOD] + ((size_t)l * 1024 + wid * 128) * 6144 + col;
      float a0 = 0.f, a1 = 0.f, a2 = 0.f;
      for (int k0 = 0; k0 < 128; k0 += 32) {
        float wv[32];
#pragma unroll
        for (int k = 0; k < 32; ++k) wv[k] = __builtin_nontemporal_load(w + (size_t)(k0 + k) * 6144);
#pragma unroll
        for (int k = 0; k < 32; ++k) { const int kk = wid * 128 + k0 + k; a0 += sin_[kk] * wv[k]; a1 += sin_[1024 + kk] * wv[k]; a2 += sin_[2048 + kk] * wv[k]; }
      }
      red[(wid * 3 + 0) * 64 + lane] = a0; red[(wid * 3 + 1) * 64 + lane] = a1; red[(wid * 3 + 2) * 64 + lane] = a2;
      __syncthreads();
      if (tid < 192) { const int v = tid >> 6, c = tid & 63; float s = p->in[I_BMOD][(size_t)l * 6144 + cg * 64 + c];
#pragma unroll
        for (int w8 = 0; w8 < 8; ++w8) s += red[(w8 * 3 + v) * 64 + c];
        MOD[((size_t)(l * 3 + v)) * 6144 + cg * 64 + c] = s; }
      __syncthreads();
    }
  }
  for (int it = bid * 4; it < p->ntiles; it += nblk * 4) {
    int jn = 0;
    for (int q = 1; q < p->njobs; ++q) if (it >= p->jobs[q].tile0) jn = q;
    TJob jb; jb.src = p->jobs[jn].src; jb.dst = p->jobs[jn].dst; jb.gs = p->jobs[jn].gs; jb.K = p->jobs[jn].K; jb.N = p->jobs[jn].N; jb.Npad = p->jobs[jn].Npad; jb.tile0 = p->jobs[jn].tile0;
    const int jend = jn + 1 < p->njobs ? p->jobs[jn + 1].tile0 : p->ntiles;
    const int ntl = jend - it < 4 ? jend - it : 4;
    transpose_tiles(jb, it - jb.tile0, ntl, lds);
  }
  convert_f16(p->in[I_EK1], (hf*)(p->ws + OFF_K1), (long)4 * 8 * 128 * 128 / 8, bid, nblk);
  convert_f16(p->in[I_EK2], (hf*)(p->ws + OFF_K2), (long)4 * 8 * 128 * 128 / 8, bid, nblk);
  for (int tb = 0; tb < 2; ++tb) {
    const float* src = p->in[tb ? I_EV : I_EU]; unsigned char* dst = (unsigned char*)(p->ws + (tb ? OFF_V8 : OFF_U8)); float* scl = (float*)(p->ws + (tb ? OFF_SV : OFF_SU));
    for (int row0 = (bid * 8 + wid) * 4; row0 < 4 * NEXP; row0 += nblk * 8 * 4) {
      f4v a[4][4];
#pragma unroll
      for (int rr = 0; rr < 4; ++rr)
#pragma unroll
        for (int k = 0; k < 4; ++k) a[rr][k] = __builtin_nontemporal_load((const f4v*)(src + (size_t)(row0 + rr) * 1024 + lane * 4 + k * 256));
#pragma unroll
      for (int rr = 0; rr < 4; ++rr) {
        const int row = row0 + rr; float mx = 0.f;
#pragma unroll
        for (int k = 0; k < 4; ++k) mx = fmaxf(mx, fmaxf(fmaxf(fabsf(a[rr][k][0]), fabsf(a[rr][k][1])), fmaxf(fabsf(a[rr][k][2]), fabsf(a[rr][k][3]))));
mx = wave_max(mx);
        const int layer = row >> 14, e = row & (NEXP - 1);
        {
          const float sc = fmaxf(mx, 1e-30f) * (1.f / 6.f), inv = 1.f / sc;
#pragma unroll
          for (int k = 0; k < 4; ++k) {
            unsigned w = __builtin_amdgcn_cvt_scalef32_pk_fp4_f32(0u, a[rr][k][0] * inv, a[rr][k][1] * inv, 1.0f, 0);
            w = __builtin_amdgcn_cvt_scalef32_pk_fp4_f32(w, a[rr][k][2] * inv, a[rr][k][3] * inv, 1.0f, 1);
            *(unsigned short*)(dst + ((size_t)(layer * 4 + k) * NEXP + e) * 128 + lane * 2) = (unsigned short)w;
          }
          if (lane == 0) { scl[row] = sc; ((hf*)(p->ws + OFF_SUVH))[2 * row + tb] = (hf)sc; }
        }
      }
    }
  }
  {
    float* cosT = (float*)(p->ws + OFF_ROPE); float* sinT = cosT + 8192 * 32;
    for (int i = bid * NTHR + tid; i < 8192 * 32; i += nblk * NTHR) {
      const int s = i >> 5, j = i & 31; const float fr = powf(10000.f, -(float)(j & 15) / 16.f);
      const float pos = (float)(j < 16 ? (s >> 6) : (s & 63)); const float ang = pos * fr;
      cosT[i] = cosf(ang); sinT[i] = sinf(ang);
    }
  }
}
PHASE void prologue_b(PP p, int bid, int nblk) {
  hf* X = (hf*)(p->ws + OFF_X); hf* H = (hf*)(p->ws + OFF_H);
  const long total = (long)MALL * 128, stride = (long)nblk * NTHR;
  for (long idx0 = (long)bid * NTHR + get_tid(); idx0 < total; idx0 += 4 * stride) {
    f4v a[4], b[4];
#pragma unroll
    for (int k = 0; k < 4; ++k) { const long idx = idx0 + k * stride; const long ii = idx < total ? idx : idx0; const int row = (int)(ii >> 7), c0 = (int)(ii & 127) * 8;
      const float* src = row < NTOK ? p->in[I_X] + (size_t)row * 1024 : p->in[I_CTX] + (size_t)(row - NTOK) * 1024;
      a[k] = *(const f4v*)(src + c0); b[k] = *(const f4v*)(src + c0 + 4); }
#pragma unroll
    for (int k = 0; k < 4; ++k) { const long idx = idx0 + k * stride; if (idx >= total) break; const int row = (int)(idx >> 7), c0 = (int)(idx & 127) * 8;
      { h8v xv = {(hf)a[k][0], (hf)a[k][1], (hf)a[k][2], (hf)a[k][3], (hf)b[k][0], (hf)b[k][1], (hf)b[k][2], (hf)b[k][3]}; *(h8v*)(X + (size_t)row * 1024 + c0) = xv; }
      const float* sh = modp(p, 0, row, 0); const float* sc = modp(p, 0, row, 1);
      h8v o;
#pragma unroll
      for (int i = 0; i < 4; ++i) { o[i] = (hf)(a[k][i] * (1.f + sc[c0 + i]) + sh[c0 + i]); o[4 + i] = (hf)(b[k][i] * (1.f + sc[c0 + 4 + i]) + sh[c0 + 4 + i]); }
      *(h8v*)(H + (size_t)row * 1024 + c0) = o; }
  }
}

constexpr int NSUB = 10;
constexpr int NPHASE = 2 + NSUB * DEPTH;
DEV void run_phase(PP p, int ph, char* lds, int bid, int nblk, bool dry, bool one_launch) {
  if (ph == 0) { prologue_a(p, lds, bid, nblk); return; }
  if (ph == 1) { prologue_b(p, bid, nblk); return; }
  const int layer = (ph - 2) / NSUB, sub = (ph - 2) - layer * NSUB, j = layer >> 1;
  const int M = layer < 2 ? MALL : NTOK;
  char* ws = p->ws;
  const float* cosT = (const float*)(ws + OFF_ROPE); const float* sinT = cosT + 8192 * 32;
  if (sub >= 4) {
    if (sub == 4) ln_phase(p, layer, 0, M, bid, nblk, dry);
    else if (sub == 5) { EpiStore e{(hf*)(ws + OFF_PQ), 2048, nullptr, nullptr, nullptr};
      gemm_phase16((const hf*)(ws + OFF_H), 1024, (const hf*)(ws + OFF_PEERWQ) + (size_t)layer * 2048 * 1024, 1024, NTOK, 2048, 1024, 0, e.out, e.ldo, e.cscale, lds, bid, nblk, dry, NTOK, M); }
    else if (sub == 6) topk_phase(p, layer, M, lds, bid, nblk);
    else if (sub == 7) peer_u_phase_dma(p, layer, M, get_role(p, lds, bid, nblk, one_launch), lds, bid, nblk);
    else if (sub == 8) peer_v_phase_dma(p, layer, M, get_role(p, lds, bid, nblk, one_launch), lds, bid, nblk);
    else ln_phase(p, layer, 1, M, bid, nblk, dry);
    return;
  }
  if ((layer & 1) == 0) {
    if (sub == 0) { EpiZ e{(hf*)(ws + OFF_Z), (hf*)(ws + OFF_KR), cosT, sinT, (float*)(ws + OFF_RSSP)};
      gemm_phase<EpiZ>((const hf*)(ws + OFF_H), 1024, (const hf*)(ws + OFF_WIN) + (size_t)j * 768 * 1024, 1024, MALL, 768, 1024, 0, e, lds, bid, nblk, dry); }
    else if (sub == 1) {
      { EpiQ e{(hf*)(ws + OFF_Q), (hf*)(ws + OFF_QC), cosT, sinT, (const float*)(ws + OFF_RSSP)};
        gemm_phase<EpiQ>((const hf*)(ws + OFF_Z), 768, (const hf*)(ws + OFF_WUQ) + (size_t)j * 1536 * 384, 384, NTOK, 1536, 384, 0, e, lds, bid, nblk, dry, NTOK, M); }
      { EpiKV e{(hf*)(ws + OFF_K), (long)((OFF_V - OFF_K) / 2), (const float*)(ws + OFF_RSSP)};
        gemm_phase<EpiKV>((const hf*)(ws + OFF_Z) + 384, 768, (const hf*)(ws + OFF_WUKV) + (size_t)j * 2048 * 256, 256, NTOK, 2048, 256, 0, e, lds, bid, nblk, dry, NTOK, MALL); }
    }
    else if (sub == 2) attn_phase(p, layer == 0, lds, bid, nblk, dry);
    else { EpiStore e{(hf*)(ws + OFF_Y), 1024, nullptr, (const hf*)(ws + OFF_X), (const float*)(ws + OFF_MOD) + ((size_t)(layer * 3) * 6 + 2) * 1024};
      gemm_phase16((const hf*)(ws + OFF_ATT), 1024, (const hf*)(ws + OFF_WO) + (size_t)j * 1024 * 1024, 1024, NTOK, 1024, 1024, 0, e.out, e.ldo, e.cscale, lds, bid, nblk, dry, NTOK, M, e.resX, e.gate0); }
  } else {
    if (sub == 0) { EpiStore e{(hf*)(ws + OFF_Z), 1024, nullptr, nullptr, nullptr};
      gemm_phase16((const hf*)(ws + OFF_H), 1024, (const hf*)(ws + OFF_PWIN) + (size_t)j * 1024 * 1024, 1024, NTOK, 1024, 1024, 0, e.out, e.ldo, e.cscale, lds, bid, nblk, dry, NTOK, M); }
    else if (sub == 1) pool_phase(p, M, bid, nblk);
    else if (sub == 2) { EpiStore e{(hf*)(ws + OFF_PQ), 1024, p->in[I_PSCALE] + (size_t)j * 1024, nullptr, nullptr};
      gemm_phase16((const hf*)(ws + OFF_ATT), 1024, (const hf*)(ws + OFF_PGRP) + (size_t)j * 1024 * 256, 256, NTOK, 1024, 256, 256, e.out, e.ldo, e.cscale, lds, bid, nblk, dry, NTOK, M); }
    else { EpiStore e{(hf*)(ws + OFF_Y), 1024, nullptr, (const hf*)(ws + OFF_X), (const float*)(ws + OFF_MOD) + ((size_t)(layer * 3) * 6 + 2) * 1024};
      gemm_phase16((const hf*)(ws + OFF_PQ), 1024, (const hf*)(ws + OFF_PWOUT) + (size_t)j * 1024 * 1024, 1024, NTOK, 1024, 1024, 0, e.out, e.ldo, e.cscale, lds, bid, nblk, dry, NTOK, M, e.resX, e.gate0); }
  }
}


#define XB_TMO      128
#define XB_XCNT(j)  (256  + 64 * (j))
#define XB_XSUB(j)  (1280 + 64 * (j))
#define XB_XGEN(j)  (2304 + 64 * (j))
#define XB_TOP      3328
#define XB_TOPGEN   3392
#define XB_RANK(j)  (3456 + 32 * (j))
#define XCD_BAR_WORDS 4096
#define XB_SPIN_CAP (1u << 22)
#define LAS __attribute__((address_space(3)))
DEV unsigned xb_ld(unsigned* p)              { return __hip_atomic_load(p, __ATOMIC_RELAXED, __HIP_MEMORY_SCOPE_AGENT); }
DEV unsigned xb_add(unsigned* p, unsigned v) { return __hip_atomic_fetch_add(p, v, __ATOMIC_RELAXED, __HIP_MEMORY_SCOPE_AGENT); }
DEV unsigned xb_xcc_id() { return (unsigned)__builtin_amdgcn_s_getreg((3 << 11) | 20) & 0xFu; }
#define XB_SPIN(cond, bar) do { unsigned _sp = 0; while (cond) { __builtin_amdgcn_s_sleep(1); \
    if ((++_sp & 255u) == 0u) { if (xb_ld(&(bar)[XB_TMO])) break; if (_sp > XB_SPIN_CAP) { atomicAdd(&(bar)[XB_TMO], 1u); break; } } } } while (0)
struct XcdBarrier { unsigned* bar; unsigned x; volatile LAS unsigned* st; };
DEV XcdBarrier xcd_barrier_post(unsigned* bar, volatile LAS unsigned* st) {
  XcdBarrier b; b.bar = bar; b.x = xb_xcc_id(); b.st = st;
  if (__builtin_amdgcn_workitem_id_x() == 0) (void)xb_add(&bar[XB_XCNT(b.x)], 1u);
  return b;
}
DEV void xcd_barrier_complete(unsigned* bar, unsigned x, unsigned& nloc, unsigned& nx) {
  const unsigned G = gridDim.x * gridDim.y * gridDim.z;
  unsigned sum, cnt, mine, sp = 0u;
  for (;;) {
    sum = 0u; cnt = 0u; mine = 0u;
#pragma unroll
    for (unsigned j = 0; j < 16; ++j) { const unsigned c = xb_ld(&bar[XB_XCNT(j)]); sum += c; cnt += (c > 0u) ? 1u : 0u; mine = (j == x) ? c : mine; }
    if (sum == G) break;
    __builtin_amdgcn_s_sleep(1);
    if ((++sp & 255u) == 0u) { if (xb_ld(&bar[XB_TMO])) break; if (sp > XB_SPIN_CAP) { atomicAdd(&bar[XB_TMO], 1u); break; } }
  }
  nloc = mine > 0u ? mine : 1u; nx = cnt > 0u ? cnt : 1u;
}
DEV void xcd_barrier(const XcdBarrier& b) {
  asm volatile("s_waitcnt vmcnt(0)" ::: "memory");
  __syncthreads();
  if (__builtin_amdgcn_workitem_id_x() == 0) {
    unsigned* bar = b.bar;
    __builtin_amdgcn_s_waitcnt(0);
    unsigned nloc = b.st[0], nx = b.st[1];
    if (nloc == 0u) { xcd_barrier_complete(bar, b.x, nloc, nx); b.st[0] = nloc; b.st[1] = nx; }
    const unsigned old = xb_add(&bar[XB_XSUB(b.x)], 1u);
    const unsigned gen = old / nloc;
    if (old + 1u == (gen + 1u) * nloc) {
      __builtin_amdgcn_fence(__ATOMIC_RELEASE, "agent");
      asm volatile("s_waitcnt vmcnt(0)" ::: "memory");
      const unsigned og = xb_add(&bar[XB_TOP], 1u);
      if (og + 1u == (gen + 1u) * nx) xb_add(&bar[XB_TOPGEN], 1u);
    }
    XB_SPIN(xb_ld(&bar[XB_TOPGEN]) == gen, bar);
    __builtin_amdgcn_fence(__ATOMIC_ACQUIRE, "agent");
    asm volatile("s_waitcnt vmcnt(0)" ::: "memory");
  }
  __syncthreads();
}

DEV PP get_params() { PP kp = (PP)__builtin_amdgcn_kernarg_segment_ptr(); asm volatile("" : "+s"(kp)); return kp; }
__global__ void __launch_bounds__(NTHR, 2) mk_kernel(Params p_in_kernarg, int ph_begin, int ph_end) {
  extern __shared__ __attribute__((aligned(16))) char lds[];
  volatile LAS unsigned* st = (volatile LAS unsigned*)(lds + LDS_TOTAL);
  const bool multi = ph_end - ph_begin > 1;
  if (__builtin_amdgcn_workitem_id_x() == 0) {
#pragma unroll
    for (int i = 0; i < CTL_WORDS; ++i) st[i] = 0u;
  }
  if (multi && blockIdx.x == 0) {
    unsigned* bar = (unsigned*)(get_params()->ws + OFF_BAR);
    for (int i = __builtin_amdgcn_workitem_id_x(); i < XCD_BAR_WORDS; i += NTHR) bar[i] = 0u;
    __threadfence();
  }
  __syncthreads();
  bool posted = false;
  for (int ph = ph_begin; ph < ph_end; ++ph) {
    const int reps = (ph == PROBE_PH) ? PROBE_N : 0;
    for (int rep = reps; rep >= 0; --rep) {
      int bid = blockIdx.x, nblk = gridDim.x; asm volatile("" : "+s"(bid), "+s"(nblk));
      if (!(PROBE_MODE == 7 && rep > 0)) run_phase(get_params(), ph, lds, bid, nblk, rep > 0, multi);
      if (ph + 1 < ph_end || rep > 0) {
        if (!posted) {
          cg::this_grid().sync();
          unsigned* bar = (unsigned*)(get_params()->ws + OFF_BAR);
          if (__builtin_amdgcn_workitem_id_x() == 0) { const unsigned x = xb_xcc_id(); st[3] = x; st[2] = xb_add(&bar[XB_RANK(x)], 1u); }
          __syncthreads();
          (void)xcd_barrier_post(bar, st);
          posted = true;
        } else { XcdBarrier xb; xb.bar = (unsigned*)(get_params()->ws + OFF_BAR); xb.x = xb_xcc_id(); xb.st = (volatile LAS unsigned*)(lds + LDS_TOTAL); xcd_barrier(xb); }
      }
    }
  }
}

static void add_job(Params& p, const float* src, hf* dst, const float* gs, int K, int N, int Npad) {
  TJob& j = p.jobs[p.njobs]; j.src = src; j.dst = dst; j.gs = gs; j.K = K; j.N = N; j.Npad = Npad; j.tile0 = p.ntiles;
  p.ntiles += (K / 64) * (Npad / 64); p.njobs++;
}
extern "C" void kernel_launch(void* const* d_in, const int* in_sizes, int n_in, void* d_out, int out_size, void* d_ws, size_t ws_size, hipStream_t stream) {
  static int grid_blocks = 0;
  if (!grid_blocks) {
    if (n_in != 23 || ws_size < WS_END) { fprintf(stderr, "kernel_launch: unexpected inputs (n_in %d, ws %zu < %zu)\n", n_in, ws_size, (size_t)WS_END); return; }
    if (hipFuncSetAttribute((const void*)mk_kernel, hipFuncAttributeMaxDynamicSharedMemorySize, LDS_TOTAL + 32) != hipSuccess) { fprintf(stderr, "kernel_launch: LDS attribute failed\n"); return; }
    int dev = 0, cus = 0, per_cu = 0;
    hipGetDevice(&dev); hipDeviceGetAttribute(&cus, hipDeviceAttributeMultiprocessorCount, dev);
    hipOccupancyMaxActiveBlocksPerMultiprocessor(&per_cu, mk_kernel, NTHR, LDS_TOTAL + 32);
    if (per_cu < 1) { fprintf(stderr, "kernel_launch: occupancy query returned %d\n", per_cu); return; }
    grid_blocks = cus;
  }
  Params p; memset(&p, 0, sizeof(p));
  for (int i = 0; i < 23; ++i) p.in[i] = (const float*)d_in[i];
  p.out = (float*)d_out; p.ws = (char*)d_ws;
  char* ws = (char*)d_ws;
  for (int j = 0; j < 2; ++j) {
    add_job(p, p.in[I_MWIN] + (size_t)j * 1024 * 704, (hf*)(ws + OFF_WIN) + (size_t)j * 768 * 1024, nullptr, 1024, 704, 768);
    add_job(p, p.in[I_MWUQ] + (size_t)j * 384 * 1536, (hf*)(ws + OFF_WUQ) + (size_t)j * 1536 * 384, p.in[I_MQN] + (size_t)j * 384, 384, 1536, 1536);
    add_job(p, p.in[I_MWUKV] + (size_t)j * 256 * 2048, (hf*)(ws + OFF_WUKV) + (size_t)j * 2048 * 256, p.in[I_MKVN] + (size_t)j * 256, 256, 2048, 2048);
    add_job(p, p.in[I_MWO] + (size_t)j * 1024 * 1024, (hf*)(ws + OFF_WO) + (size_t)j * 1024 * 1024, nullptr, 1024, 1024, 1024);
    add_job(p, p.in[I_PWIN] + (size_t)j * 1024 * 1024, (hf*)(ws + OFF_PWIN) + (size_t)j * 1024 * 1024, nullptr, 1024, 1024, 1024);
    add_job(p, p.in[I_PWOUT] + (size_t)j * 1024 * 1024, (hf*)(ws + OFF_PWOUT) + (size_t)j * 1024 * 1024, nullptr, 1024, 1024, 1024);
    for (int g = 0; g < 4; ++g)
      add_job(p, p.in[I_PGRP] + ((size_t)j * 4 + g) * 256 * 256, (hf*)(ws + OFF_PGRP) + ((size_t)j * 1024 + g * 256) * 256, nullptr, 256, 256, 256);
  }
  for (int l = 0; l < 4; ++l)
    add_job(p, p.in[I_EWQ] + (size_t)l * 1024 * 2048, (hf*)(ws + OFF_PEERWQ) + (size_t)l * 2048 * 1024, nullptr, 1024, 2048, 2048);
#if MK_ONE_LAUNCH
  int b = 0, e = NPHASE; void* args[] = {&p, &b, &e};
  hipError_t err = hipLaunchCooperativeKernel((const void*)mk_kernel, dim3(grid_blocks), dim3(NTHR), args, LDS_TOTAL + 32, stream);
  if (err != hipSuccess) fprintf(stderr, "cooperative launch failed: %s\n", hipGetErrorString(err));
#else
  for (int ph = 0; ph < NPHASE; ++ph) hipLaunchKernelGGL(mk_kernel, dim3(grid_blocks), dim3(NTHR), LDS_TOTAL + 32, stream, p, ph, ph + 1);
#endif
}
```
